# Optimizing an MI355X kernel written in HIP

```python
import jax, jax.numpy as jnp
from jax import lax
import numpy as np

D_MODEL = 2048
BATCH = 4
SEQ = 4096
DEPTH = 2

N_EVEN = (DEPTH + 1) // 2
N_ODD = DEPTH // 2
N_MEM = 256
ROPE_THETA = 500000.0
ROT_FRAC = 4
EPS = 1e-6
Q_BLOCK = 128

MLA_HEADS = 8
MLA_Q_RANK = 512
MLA_KV_RANK = 256
MLA_NOPE = 128
MLA_ROPE = 64
MLA_V = 128
MOBA_HEADS = 8
MOBA_DH = 128
MOBA_BLOCK = 256
MOBA_TOPK = 3
MOBA_QCHUNK = 32
SWA_HEADS = 16
SWA_KV_HEADS = 2
SWA_DH = 64
SWA_WINDOW = 128
DIL_HEADS = 6
DIL_DH = 128
DIL_PATTERNS = ((128, 1), (512, 4), (2048, 16))
MEM_HEADS = 4
MEM_DH = 128

MEMQ_W = MEM_HEADS * MEM_DH
EVEN_VW = MLA_HEADS * MLA_V + MOBA_HEADS * MOBA_DH + MEMQ_W
EVEN_SPLITS = (MLA_Q_RANK, MLA_KV_RANK, MLA_ROPE, 3 * MOBA_HEADS * MOBA_DH, MEMQ_W, EVEN_VW)
EVEN_IN = sum(EVEN_SPLITS)
ODD_VW = SWA_HEADS * SWA_DH + DIL_HEADS * DIL_DH + MEMQ_W
ODD_SPLITS = ((SWA_HEADS + 2 * SWA_KV_HEADS) * SWA_DH, 3 * DIL_HEADS * DIL_DH, MEMQ_W, ODD_VW)
ODD_IN = sum(ODD_SPLITS)

kernel_name = "hybrid_mla_moba_swa_dilated_memory"


def split_cols(h, sizes):
    return jnp.split(h, [int(i) for i in np.cumsum(sizes)[:-1]], axis=-1)


def rms_norm(x, g):
    xf = x.astype(jnp.float32)
    y = xf * lax.rsqrt(jnp.mean(xf * xf, axis=-1, keepdims=True) + EPS)
    return (y * g.astype(jnp.float32)).astype(x.dtype)


def apply_rope(x, rot_dim):
    S = x.shape[1]
    inv = 1.0 / (ROPE_THETA ** (jnp.arange(0, rot_dim, 2, dtype=jnp.float32) / rot_dim))
    ang = jnp.arange(S, dtype=jnp.float32)[:, None] * inv[None, :]
    c, s = jnp.cos(ang)[None, :, None, :], jnp.sin(ang)[None, :, None, :]
    xr = x[..., :rot_dim].astype(jnp.float32)
    x1, x2 = xr[..., : rot_dim // 2], xr[..., rot_dim // 2:]
    rot = jnp.concatenate([x1 * c - x2 * s, x1 * s + x2 * c], axis=-1).astype(x.dtype)
    return jnp.concatenate([rot, x[..., rot_dim:]], axis=-1)


def causal_attention_qblocks(q, k, v, scale):
    B, H, S, dq = q.shape
    nb = S // Q_BLOCK
    qb = q.reshape(B, H, nb, Q_BLOCK, dq).transpose(2, 0, 1, 3, 4)
    kpos = jnp.arange(S)

    def one(args):
        qi, n = args
        s = jnp.einsum('bhqd,bhkd->bhqk', qi, k).astype(jnp.float32) * scale
        qpos = n * Q_BLOCK + jnp.arange(Q_BLOCK)
        s = jnp.where(kpos[None, :] <= qpos[:, None], s, -jnp.inf)
        p = jax.nn.softmax(s, axis=-1).astype(v.dtype)
        return jnp.einsum('bhqk,bhkd->bhqd', p, v)

    o = lax.map(one, (qb, jnp.arange(nb)))
    return o.transpose(1, 2, 0, 3, 4).reshape(B, H, S, v.shape[-1])


def moba_attention(q, k, v):
    B, H, S, dh = q.shape
    L = MOBA_BLOCK
    nblk = -(-S // L)
    Sp = nblk * L
    pad = ((0, 0), (0, 0), (0, Sp - S), (0, 0))
    kb = jnp.pad(k, pad).reshape(B, H, nblk, L, dh)
    vb = jnp.pad(v, pad).reshape(B, H, nblk, L, dh)
    kmean = jnp.mean(kb.astype(jnp.float32), axis=3)
    topk = min(MOBA_TOPK, nblk - 1)
    scale = dh ** -0.5
    QC = MOBA_QCHUNK
    nc = S // QC
    qc = q.reshape(B, H, nc, QC, dh).transpose(2, 0, 1, 3, 4)
    offs = jnp.arange(L)
    gather = jax.vmap(jax.vmap(lambda t, i: t[i]))

    def one(args):
        qi, c = args
        blk = (c * QC) // L
        qpos = c * QC + jnp.arange(QC)
        k_own = lax.dynamic_index_in_dim(kb, blk, axis=2, keepdims=False)
        v_own = lax.dynamic_index_in_dim(vb, blk, axis=2, keepdims=False)
        s_own = jnp.einsum('bhqd,bhld->bhql', qi, k_own).astype(jnp.float32) * scale
        s_own = jnp.where((blk * L + offs)[None, :] <= qpos[:, None], s_own, -jnp.inf)
        if topk == 0:
            p = jax.nn.softmax(s_own, axis=-1).astype(v.dtype)
            return jnp.einsum('bhql,bhld->bhqd', p, v_own)
        gate = jnp.einsum('bhqd,bhnd->bhqn', qi.astype(jnp.float32), kmean)
        gate = jnp.where(jnp.arange(nblk) < blk, gate, -jnp.inf)
        _, idx = lax.top_k(gate, topk)
        valid = jnp.arange(topk) < blk
        kg = gather(kb, idx)
        vg = gather(vb, idx)
        s_sel = jnp.einsum('bhqd,bhqkld->bhqkl', qi, kg).astype(jnp.float32) * scale
        s_sel = jnp.where(valid[:, None], s_sel, -jnp.inf)
        s_all = jnp.concatenate([s_sel.reshape(B, H, QC, topk * L), s_own], axis=-1)
        p = jax.nn.softmax(s_all, axis=-1).astype(v.dtype)
        p_sel = p[..., : topk * L].reshape(B, H, QC, topk, L)
        return (jnp.einsum('bhqkl,bhqkld->bhqd', p_sel, vg)
                + jnp.einsum('bhql,bhld->bhqd', p[..., topk * L:], v_own))

    o = lax.map(one, (qc, jnp.arange(nc)))
    return o.transpose(1, 2, 0, 3, 4).reshape(B, H, S, dh)


def banded_attention(q, k, v, max_dist, scale):
    B, Hk, G, L, dh = q.shape
    QB = Q_BLOCK
    nb = -(-L // QB)
    Lp = nb * QB
    qp = jnp.pad(q, ((0, 0), (0, 0), (0, 0), (0, Lp - L), (0, 0))).reshape(B, Hk, G, nb, QB, dh)
    kp = jnp.pad(k, ((0, 0), (0, 0), (QB, Lp - L), (0, 0)))
    vp = jnp.pad(v, ((0, 0), (0, 0), (QB, Lp - L), (0, 0)))
    kband = jnp.concatenate([kp[:, :, :Lp].reshape(B, Hk, nb, QB, dh),
                             kp[:, :, QB:].reshape(B, Hk, nb, QB, dh)], axis=3)
    vband = jnp.concatenate([vp[:, :, :Lp].reshape(B, Hk, nb, QB, dh),
                             vp[:, :, QB:].reshape(B, Hk, nb, QB, dh)], axis=3)
    s = jnp.einsum('bkgnqd,bknsd->bkgnqs', qp, kband).astype(jnp.float32) * scale
    dist = QB + jnp.arange(QB)[:, None] - jnp.arange(2 * QB)[None, :]
    kpos = jnp.arange(nb)[:, None] * QB - QB + jnp.arange(2 * QB)[None, :]
    mask = ((dist >= 0) & (dist <= max_dist))[None] & (kpos >= 0)[:, None, :]
    s = jnp.where(mask, s, -jnp.inf)
    m = jnp.max(s, axis=-1, keepdims=True)
    p = jnp.exp(s - m)
    l = jnp.sum(p, axis=-1, keepdims=True)
    o = jnp.einsum('bkgnqs,bknsd->bkgnqd', (p / l).astype(v.dtype), vband)
    lse = (m + jnp.log(l))[..., 0]
    return (o.reshape(B, Hk, G, Lp, dh)[:, :, :, :L], lse.reshape(B, Hk, G, Lp)[:, :, :, :L])


def dilated_attention(q, k, v):
    B, S, H, dh = q.shape
    outs, lses = [], []
    for window, dil in DIL_PATTERNS:
        L = S // dil

        def to_sub(t):
            return t.reshape(B, L, dil, H, dh).transpose(0, 2, 3, 1, 4).reshape(B * dil, H, L, dh)

        o, lse = banded_attention(to_sub(q)[:, :, None], to_sub(k), to_sub(v), window // dil, dh ** -0.5)
        outs.append(o[:, :, 0].reshape(B, dil, H, L, dh).transpose(0, 3, 1, 2, 4).reshape(B, S, H, dh))
        lses.append(lse[:, :, 0].reshape(B, dil, H, L).transpose(0, 3, 1, 2).reshape(B, S, H))
    w = jax.nn.softmax(jnp.stack(lses, axis=0), axis=0)
    return jnp.sum(w[..., None] * jnp.stack(outs, axis=0).astype(jnp.float32), axis=0).astype(q.dtype)


def memory_attention(q_mem, mem, mem_norm_g, w_mem_kv):
    B, S, _ = q_mem.shape
    kv = (rms_norm(mem, mem_norm_g) @ w_mem_kv).reshape(B, -1, 2, MEM_HEADS, MEM_DH)
    q = q_mem.reshape(B, S, MEM_HEADS, MEM_DH)
    s = jnp.einsum('bshd,bmhd->bhsm', q, kv[:, :, 0]).astype(jnp.float32) * MEM_DH ** -0.5
    p = jax.nn.softmax(s, axis=-1).astype(q.dtype)
    return jnp.einsum('bhsm,bmhd->bshd', p, kv[:, :, 1]).reshape(B, S, MEMQ_W)


def even_layer(x, mem, norm_g, w_in, q_norm_g, w_uq, kv_norm_g, w_ukv, mem_norm_g, w_mem_kv, w_out):
    B, S, _ = x.shape
    h = rms_norm(x, norm_g) @ w_in
    c_q, c_kv, k_pe, qkv_b, q_mem, gate = split_cols(h, EVEN_SPLITS)
    q_a = (rms_norm(c_q, q_norm_g) @ w_uq).reshape(B, S, MLA_HEADS, MLA_NOPE + MLA_ROPE)
    q_a = jnp.concatenate([q_a[..., :MLA_NOPE], apply_rope(q_a[..., MLA_NOPE:], MLA_ROPE)], axis=-1)
    kv_a = (rms_norm(c_kv, kv_norm_g) @ w_ukv).reshape(B, S, MLA_HEADS, MLA_NOPE + MLA_V)
    k_pe = apply_rope(k_pe[:, :, None, :], MLA_ROPE)
    k_a = jnp.concatenate([kv_a[..., :MLA_NOPE],
                           jnp.broadcast_to(k_pe, (B, S, MLA_HEADS, MLA_ROPE))], axis=-1)
    v_a = kv_a[..., MLA_NOPE:]
    o_a = causal_attention_qblocks(q_a.transpose(0, 2, 1, 3), k_a.transpose(0, 2, 1, 3),
                                   v_a.transpose(0, 2, 1, 3), (MLA_NOPE + MLA_ROPE) ** -0.5)
    o_a = o_a.transpose(0, 2, 1, 3).reshape(B, S, MLA_HEADS * MLA_V)
    qkv_b = qkv_b.reshape(B, S, 3, MOBA_HEADS, MOBA_DH)
    rot = MOBA_DH // ROT_FRAC
    q_b = apply_rope(qkv_b[:, :, 0], rot).transpose(0, 2, 1, 3)
    k_b = apply_rope(qkv_b[:, :, 1], rot).transpose(0, 2, 1, 3)
    v_b = qkv_b[:, :, 2].transpose(0, 2, 1, 3)
    o_b = moba_attention(q_b, k_b, v_b).transpose(0, 2, 1, 3).reshape(B, S, MOBA_HEADS * MOBA_DH)
    o_m = memory_attention(q_mem, mem, mem_norm_g, w_mem_kv)
    y = jnp.concatenate([o_a, o_b.astype(o_a.dtype), o_m.astype(o_a.dtype)], axis=-1) * jax.nn.silu(gate)
    return x + (y @ w_out).astype(x.dtype)


def odd_layer(x, mem, norm_g, w_in, sinks, mem_norm_g, w_mem_kv, w_out):
    B, S, _ = x.shape
    h = rms_norm(x, norm_g) @ w_in
    qkv_c, qkv_d, q_mem, gate = split_cols(h, ODD_SPLITS)
    q_c, k_c, v_c = split_cols(qkv_c, (SWA_HEADS * SWA_DH, SWA_KV_HEADS * SWA_DH, SWA_KV_HEADS * SWA_DH))
    rot_c = SWA_DH // ROT_FRAC
    G = SWA_HEADS // SWA_KV_HEADS
    q_c = apply_rope(q_c.reshape(B, S, SWA_HEADS, SWA_DH), rot_c)
    k_c = apply_rope(k_c.reshape(B, S, SWA_KV_HEADS, SWA_DH), rot_c)
    v_c = v_c.reshape(B, S, SWA_KV_HEADS, SWA_DH)
    qg = q_c.reshape(B, S, SWA_KV_HEADS, G, SWA_DH).transpose(0, 2, 3, 1, 4)
    o_c, lse_c = banded_attention(qg, k_c.transpose(0, 2, 1, 3), v_c.transpose(0, 2, 1, 3),
                                  SWA_WINDOW - 1, SWA_DH ** -0.5)
    o_c = o_c.transpose(0, 3, 1, 2, 4).reshape(B, S, SWA_HEADS, SWA_DH)
    lse_c = lse_c.transpose(0, 3, 1, 2).reshape(B, S, SWA_HEADS)
    sink_w = jax.nn.sigmoid(lse_c - sinks.astype(jnp.float32))
    o_c = (o_c.astype(jnp.float32) * sink_w[..., None]).astype(x.dtype).reshape(B, S, SWA_HEADS * SWA_DH)
    qkv_d = qkv_d.reshape(B, S, 3, DIL_HEADS, DIL_DH)
    rot_d = DIL_DH // ROT_FRAC
    o_d = dilated_attention(apply_rope(qkv_d[:, :, 0], rot_d), apply_rope(qkv_d[:, :, 1], rot_d),
                            qkv_d[:, :, 2]).reshape(B, S, DIL_HEADS * DIL_DH)
    o_m = memory_attention(q_mem, mem, mem_norm_g, w_mem_kv)
    y = jnp.concatenate([o_c, o_d.astype(o_c.dtype), o_m.astype(o_c.dtype)], axis=-1) * jax.nn.silu(gate).astype(o_c.dtype)
    return x + (y @ w_out).astype(x.dtype)


def setup_inputs(seed: int = 0) -> dict:
    key = jax.random.key(seed)
    ks = jax.random.split(key, 20)

    def dense(k, shape):
        return jax.random.normal(k, shape, jnp.float32) * shape[-2] ** -0.5

    def gain(k, shape):
        return 1.0 + 0.02 * jax.random.normal(k, shape, jnp.float32)

    return {
        "x": jax.random.normal(ks[0], (BATCH, SEQ, D_MODEL), jnp.float32),
        "mem": jax.random.normal(ks[1], (BATCH, N_MEM, D_MODEL), jnp.float32),
        "ev_norm_g": gain(ks[2], (N_EVEN, D_MODEL)),
        "ev_w_in": dense(ks[3], (N_EVEN, D_MODEL, EVEN_IN)),
        "ev_q_norm_g": gain(ks[4], (N_EVEN, MLA_Q_RANK)),
        "ev_w_uq": dense(ks[5], (N_EVEN, MLA_Q_RANK, MLA_HEADS * (MLA_NOPE + MLA_ROPE))),
        "ev_kv_norm_g": gain(ks[6], (N_EVEN, MLA_KV_RANK)),
        "ev_w_ukv": dense(ks[7], (N_EVEN, MLA_KV_RANK, MLA_HEADS * (MLA_NOPE + MLA_V))),
        "ev_mem_norm_g": gain(ks[8], (N_EVEN, D_MODEL)),
        "ev_w_mem_kv": dense(ks[9], (N_EVEN, D_MODEL, 2 * MEMQ_W)),
        "ev_w_out": dense(ks[10], (N_EVEN, EVEN_VW, D_MODEL)),
        "od_norm_g": gain(ks[11], (N_ODD, D_MODEL)),
        "od_w_in": dense(ks[12], (N_ODD, D_MODEL, ODD_IN)),
        "od_sinks": 0.5 * jax.random.normal(ks[13], (N_ODD, SWA_HEADS), jnp.float32),
        "od_mem_norm_g": gain(ks[14], (N_ODD, D_MODEL)),
        "od_w_mem_kv": dense(ks[15], (N_ODD, D_MODEL, 2 * MEMQ_W)),
        "od_w_out": dense(ks[16], (N_ODD, ODD_VW, D_MODEL)),
        "final_norm_g": gain(ks[17], (D_MODEL,)),
    }


def reference(x, mem, ev_norm_g, ev_w_in, ev_q_norm_g, ev_w_uq, ev_kv_norm_g, ev_w_ukv,
              ev_mem_norm_g, ev_w_mem_kv, ev_w_out, od_norm_g, od_w_in, od_sinks,
              od_mem_norm_g, od_w_mem_kv, od_w_out, final_norm_g):
    for layer in range(DEPTH):
        i = layer // 2
        if layer % 2 == 0:
            x = even_layer(x, mem, ev_norm_g[i], ev_w_in[i], ev_q_norm_g[i], ev_w_uq[i],
                           ev_kv_norm_g[i], ev_w_ukv[i], ev_mem_norm_g[i], ev_w_mem_kv[i], ev_w_out[i])
        else:
            x = odd_layer(x, mem, od_norm_g[i], od_w_in[i], od_sinks[i], od_mem_norm_g[i],
                          od_w_mem_kv[i], od_w_out[i])
    return rms_norm(x, final_norm_g)
```

```cpp
#include <hip/hip_runtime.h>
#include <hip/hip_cooperative_groups.h>
#include <cstdio>
#include <cstdint>
namespace cg = cooperative_groups;

#ifndef WGM_OUT
#define WGM_OUT 4
#endif
typedef unsigned short bf16_t;
typedef short bf16x8 __attribute__((ext_vector_type(8)));
typedef float f32x4 __attribute__((ext_vector_type(4)));
typedef float f32x2 __attribute__((ext_vector_type(2)));
typedef unsigned u32x4 __attribute__((ext_vector_type(4)));
typedef unsigned u32x2 __attribute__((ext_vector_type(2)));
#define LAS __attribute__((address_space(3)))

constexpr int NB = 4, SEQ = 4096, DM = 2048, T = NB * SEQ, NMEM = 256;
constexpr int LDH0 = 7168, LDH1 = 6400;
constexpr float EPS = 1e-6f;
constexpr int E_CQ = 0, E_CKV = 512, E_KPE = 768, E_QB = 1024, E_KB = 2048, E_VB = 3072, E_QM = 4096, E_G = 4608;
constexpr int O_QC = 0, O_KC = 1024, O_VC = 1152, O_QD = 1280, O_KD = 2048, O_VD = 2816, O_QM = 3584, O_G = 4096;

constexpr size_t MiB = 1u << 20;
constexpr size_t WS_W1E = 0, WS_WUQ = 28 * MiB, WS_WUKV = 30 * MiB, WS_WMKE = 31 * MiB, WS_WOE = 35 * MiB, WS_W1O = 45 * MiB,
                 WS_WMKO = 70 * MiB, WS_WOO = 74 * MiB;
constexpr size_t WS_R1 = 96 * MiB;
constexpr size_t WS_KVA = WS_R1 + 64 * MiB;
constexpr size_t WS_H = 224 * MiB;
constexpr size_t WS_MISC = 448 * MiB;
constexpr size_t WS_MEMB = WS_MISC, WS_MKVE = WS_MISC + 4 * MiB, WS_MKVO = WS_MISC + 6 * MiB;
constexpr size_t WS_CS64 = WS_MISC + 8 * MiB, WS_CS32 = WS_MISC + 9 * MiB, WS_CS16 = WS_MISC + 9 * MiB + 512 * 1024;
constexpr size_t WS_RS0 = WS_MISC + 10 * MiB, WS_SSQQ = WS_RS0 + 65536, WS_SSQKV = WS_RS0 + 2 * 65536, WS_SSQ1 = WS_RS0 + 3 * 65536,
                 WS_SSQ2 = WS_RS0 + 4 * 65536, WS_RSMEM = WS_RS0 + 5 * 65536;
constexpr size_t WS_KMEAN = WS_MISC + 11 * MiB;
constexpr size_t WS_LSE = WS_MISC + 12 * MiB;
constexpr size_t WS_CTL = WS_MISC + 14 * MiB;
constexpr size_t WS_KD = 424 * MiB, WS_VD = 464 * MiB;
constexpr size_t WS_KC = 488 * MiB, WS_VC = 492 * MiB;
constexpr size_t WS_END = 496 * MiB;
__host__ __device__ constexpr size_t ws_op(int p) { return p == 0 ? (size_t)0 : WS_R1 + (size_t)(64 + 24 * (p - 1)) * MiB; }

struct Args { const float* in[18]; float* out; unsigned char* ws; int ph_lo, ph_hi; };

__device__ __forceinline__ int lane_id() { int r = (int)__builtin_amdgcn_mbcnt_hi(~0u, __builtin_amdgcn_mbcnt_lo(~0u, 0u)); asm volatile("" : "+v"(r)); return r; }
template <int MASK> __device__ __forceinline__ float swz_xor(float v) { return __uint_as_float((unsigned)__builtin_amdgcn_ds_swizzle((int)__float_as_uint(v), (MASK << 10) | 0x1F)); }
__device__ __forceinline__ float sum_x32(float v) { auto rr = __builtin_amdgcn_permlane32_swap(__float_as_uint(v), __float_as_uint(v), false, false); return __uint_as_float(rr[0]) + __uint_as_float(rr[1]); }
__device__ __forceinline__ float max_x32(float v) { auto rr = __builtin_amdgcn_permlane32_swap(__float_as_uint(v), __float_as_uint(v), false, false); return fmaxf(__uint_as_float(rr[0]), __uint_as_float(rr[1])); }
__device__ __forceinline__ float xchg_x32(float v) { auto rr = __builtin_amdgcn_permlane32_swap(__float_as_uint(v), __float_as_uint(v), false, false); return __uint_as_float(rr[0] ^ rr[1] ^ __float_as_uint(v)); }
__device__ __forceinline__ float bf2f(bf16_t b) { return __uint_as_float((unsigned)b << 16); }
typedef __bf16 bf16x2_t __attribute__((ext_vector_type(2)));
__device__ __forceinline__ unsigned cvt_pk_bf16(float lo, float hi) { const f32x2 v = {lo, hi}; return __builtin_bit_cast(unsigned, __builtin_convertvector(v, bf16x2_t)); }
__device__ __forceinline__ float wave_sum(float v) {
    v += swz_xor<1>(v); v += swz_xor<2>(v); v += swz_xor<4>(v); v += swz_xor<8>(v); v += swz_xor<16>(v); return sum_x32(v);
}
__device__ __forceinline__ float wave_max(float v) {
    v = fmaxf(v, swz_xor<1>(v)); v = fmaxf(v, swz_xor<2>(v)); v = fmaxf(v, swz_xor<4>(v)); v = fmaxf(v, swz_xor<8>(v)); v = fmaxf(v, swz_xor<16>(v)); return max_x32(v);
}

__device__ __forceinline__ void blockmap(int mat, int db, int& src, int& half) {
    src = 64 * db; half = 0;
    if (mat == 0) {
        if (db < 12) return;
        if (db == 12) { half = 32; return; }
        if (db < 16) { src = -1; return; }
        if (db < 64) { const int j = 64 * db - 1024; src = 832 + j; if ((j >> 10) < 2 && (j & 127) == 0) half = 16; return; }
        if (db < 72) { src = 3904 + (64 * db - 4096); return; }
        src = 4416 + (64 * db - 4608); return;
    }
    if (mat == 1) { if (db % 3 == 2) half = 32; return; }
    if (mat == 5) { if (db < 18) half = 8; else if (db >= 20 && db < 56) { const int j = 64 * db - 1280; if (j / 768 < 2 && (j & 127) == 0) half = 16; } return; }
}
__device__ __forceinline__ void transpose_item(const float* W, int K, int Nsrc, bf16_t* WT, const float* g, int mat, LAS float* scr, int item, int nblk, int lane) {
    const int kb = item / nblk, db = item - kb * nblk, k0 = 64 * kb, n0 = 64 * db;
    int src, half; blockmap(mat, db, src, half);
    const int s4 = 4 * (lane & 15), kr = lane >> 4;
    f32x4 v[16];
    if (src >= 0) {
#pragma unroll
        for (int i = 0; i < 16; ++i) v[i] = *(const f32x4*)(W + (size_t)(k0 + kr + 4 * i) * Nsrc + src + s4);
        if (g) {
#pragma unroll
            for (int i = 0; i < 16; ++i) v[i] = v[i] * g[k0 + kr + 4 * i];
        }
    } else {
#pragma unroll
        for (int i = 0; i < 16; ++i) v[i] = (f32x4){0.f, 0.f, 0.f, 0.f};
    }
    int dr[4];
#pragma unroll
    for (int e = 0; e < 4; ++e) { const int sc_ = s4 + e; dr[e] = sc_ < 2 * half ? (sc_ < half ? 2 * sc_ : 2 * (sc_ - half) + 1) : sc_; }
#pragma unroll
    for (int i = 0; i < 16; ++i) { LAS float* rowp = scr + (kr + 4 * i) * 65; rowp[dr[0]] = v[i].x; rowp[dr[1]] = v[i].y; rowp[dr[2]] = v[i].z; rowp[dr[3]] = v[i].w; }
    asm volatile("s_waitcnt lgkmcnt(0)" ::: "memory");
    const int c = lane & 7;
#pragma unroll
    for (int j = 0; j < 8; ++j) { const int n = (lane >> 3) + 8 * j; const LAS float* sp = scr + (8 * c) * 65 + n;
        u32x4 o; o.x = cvt_pk_bf16(sp[0 * 65], sp[1 * 65]); o.y = cvt_pk_bf16(sp[2 * 65], sp[3 * 65]); o.z = cvt_pk_bf16(sp[4 * 65], sp[5 * 65]); o.w = cvt_pk_bf16(sp[6 * 65], sp[7 * 65]);
        *(u32x4*)(WT + (size_t)(n0 + n) * K + k0 + 8 * c) = o; }
    asm volatile("s_waitcnt lgkmcnt(0)" ::: "memory");
}

__device__ __forceinline__ void row_to_bf16(const float* xrow, bf16_t* orow, float* rs, int lane) {
    const f32x4* xr = (const f32x4*)xrow + lane; f32x4 v[8]; float s = 0.f;
#pragma unroll
    for (int j = 0; j < 8; ++j) { v[j] = xr[64 * j]; s += (v[j].x * v[j].x + v[j].y * v[j].y) + (v[j].z * v[j].z + v[j].w * v[j].w); }
    s = wave_sum(s);
    if (lane == 0) *rs = 1.0f / sqrtf(s * (1.0f / DM) + EPS);
    u32x2* o8 = (u32x2*)orow + lane;
#pragma unroll
    for (int j = 0; j < 8; ++j) { u32x2 w; w.x = cvt_pk_bf16(v[j].x, v[j].y); w.y = cvt_pk_bf16(v[j].z, v[j].w); o8[64 * j] = w; }
}

namespace pg8 {
constexpr int BM = 256, BK = 64, HALF = 128, HTB = HALF * BK * 2, STAGE_BYTES = 8 * HTB, NXCD = 8;
__host__ __device__ __forceinline__ int lds_byte(int r, int c) { const int st = (r >> 4) * 2 + (c >> 5), rr = r & 15, cc = c & 31, ob = rr * 64 + cc * 2; return st * 1024 + (ob ^ (((ob >> 9) & 1) << 5)); }
__host__ __device__ __forceinline__ void stage_rc(int b, int& R, int& C) { const int st = b / 1024, sb = b % 1024, swz = sb ^ (((sb >> 9) & 1) << 5); R = (st >> 1) * 16 + swz / 64; C = (st & 1) * 32 + (swz % 64) / 2; }
__host__ __device__ __forceinline__ int perm32(int rho) { const int n = rho >> 4, i = rho & 15; return 8 * (i >> 2) + 4 * n + (i & 3); }
struct Unit { int pm, pn; };
struct Gemm { const bf16_t* A; const bf16_t* Bt; int M, N, K, lda; };
struct StaticOrder {
    int nM, nN, nwg, G, c, WGM;
    __host__ __device__ void init(int M, int N, int G_, int c_, int wgm_ = 2) { nM = M / BM; nN = N / BM; nwg = nM * nN; G = G_; c = c_; WGM = wgm_; }
    __host__ __device__ void unit_of(int L, Unit& u) const {
        int wgid = L; { const int q = nwg / NXCD, r = nwg % NXCD, xcd = wgid % NXCD, off = wgid / NXCD; wgid = (xcd < r ? xcd * (q + 1) : r * (q + 1) + (xcd - r) * q) + off; }
        const int nig = WGM * nN, gid = wgid / nig, fm = gid * WGM, gsz = (nM - fm) < WGM ? (nM - fm) : WGM;
        u.pm = fm + ((wgid % nig) % gsz); u.pn = (wgid % nig) / gsz;
    }
    __host__ __device__ bool next(int i, Unit& u) const {
        if (c < 0) return false;
        const long L = (long)i * G + c; if (L >= nwg) return false;
        unit_of((int)L, u); return true;
    }
};

template <class Epi, class Sched>
__device__ __forceinline__ void gemm_phase(LAS unsigned char* lds, const Gemm g, const Sched& S, const Epi& E, const int wid) {
    const int lane = lane_id(), tid = wid * 64 + lane, wr = wid >> 2, wc = wid & 3, fr = lane & 15, fq = lane >> 4;
    const int K = g.K, nt = K / BK;
    unsigned voffA[2], voffB[2];
#pragma unroll
    for (int i = 0; i < 2; ++i) { int R, C; stage_rc(tid * 16 + i * 8192, R, C); const int Rb = (R & ~31) + perm32(R & 31); voffA[i] = (unsigned)(R * g.lda + C) * 2u; voffB[i] = (unsigned)(Rb * K + C) * 2u; }
    const size_t kstep = (size_t)(BK * 2);
    const size_t hstepA = (size_t)HALF * g.lda * 2, hstepB = (size_t)HALF * K * 2, tstepA = 2 * hstepA, tstepB = 2 * hstepB;
    const unsigned ldsw = (unsigned)wid * 1024u;
    const int aoff = lds_byte(wr * 64 + fr, fq * 8), boff = lds_byte(wc * 32 + fr, fq * 8);
#define PG8_SA(b, h) (((b) * 2 + (h)) * HTB)
#define PG8_SB(b, h) ((4 + (b) * 2 + (h)) * HTB)
#define PG8_STAGE(bufoff, gbase, voff) do { _Pragma("unroll") for (int _i = 0; _i < 2; ++_i) \
        __builtin_amdgcn_global_load_lds((const unsigned*)((const char*)(gbase) + (voff)[_i]), (LAS unsigned*)(lds + (bufoff) + ldsw + _i * 8192), 16, 0, 0); } while (0)
#define PG8_LDA(dst, b, h) do { _Pragma("unroll") for (int m = 0; m < 4; ++m) _Pragma("unroll") for (int k = 0; k < 2; ++k) dst[m][k] = *(const LAS bf16x8*)(lds + PG8_SA(b, h) + aoff + m * 2048 + k * 1024); } while (0)
#define PG8_LDB(dst, b, h) do { _Pragma("unroll") for (int n = 0; n < 2; ++n) _Pragma("unroll") for (int k = 0; k < 2; ++k) dst[n][k] = *(const LAS bf16x8*)(lds + PG8_SB(b, h) + boff + n * 2048 + k * 1024); } while (0)
#define PG8_MMA(ai, bj, At, Bt) do { __builtin_amdgcn_s_setprio(1); _Pragma("unroll") for (int m = 0; m < 4; ++m) _Pragma("unroll") for (int n = 0; n < 2; ++n) _Pragma("unroll") for (int k = 0; k < 2; ++k) \
        acc[ai][bj][m][n] = __builtin_amdgcn_mfma_f32_16x16x32_bf16(Bt[n][k], At[m][k], acc[ai][bj][m][n], 0, 0, 0); __builtin_amdgcn_s_setprio(0); } while (0)
#define PG8_WAIT_V(n) asm volatile("s_waitcnt vmcnt(" #n ")" ::: "memory")
#define PG8_WAIT_L(n) asm volatile("s_waitcnt lgkmcnt(" #n ")" ::: "memory")
#define PG8_BAR __builtin_amdgcn_s_barrier()
#define PG8_SCHED __builtin_amdgcn_sched_barrier(0)
    Unit cur, nxt; int ui = 0;
    if (!S.next(0, cur)) return;
    f32x4 acc[2][2][4][2];
#pragma unroll
    for (int a = 0; a < 2; ++a)
#pragma unroll
        for (int b = 0; b < 2; ++b)
#pragma unroll
            for (int m = 0; m < 4; ++m)
#pragma unroll
                for (int n = 0; n < 2; ++n) acc[a][b][m][n] = (f32x4){0.f, 0.f, 0.f, 0.f};
    bf16x8 At[4][2], B0[2][2], B1[2][2];
    const char* cA = (const char*)g.A + (size_t)cur.pm * tstepA; const char* cB = (const char*)g.Bt + (size_t)cur.pn * tstepB;
    PG8_STAGE(PG8_SB(0, 0), cB, voffB); PG8_STAGE(PG8_SB(0, 1), cB + hstepB, voffB); PG8_STAGE(PG8_SA(0, 0), cA, voffA); PG8_STAGE(PG8_SA(0, 1), cA + hstepA, voffA);
    if (wr == 1) PG8_BAR;
    PG8_WAIT_V(2); PG8_BAR;
    PG8_STAGE(PG8_SB(1, 0), cB + kstep, voffB); PG8_STAGE(PG8_SA(1, 0), cA + kstep, voffA); PG8_STAGE(PG8_SB(1, 1), cB + hstepB + kstep, voffB);
    PG8_WAIT_V(6); PG8_BAR;
    for (;;) {
        const bool has_next = S.next(ui + 1, nxt);
        const char* nA = has_next ? (const char*)g.A + (size_t)nxt.pm * tstepA : cA; const char* nB = has_next ? (const char*)g.Bt + (size_t)nxt.pn * tstepB : cB;
#pragma unroll 1
        for (int t = 0; t < nt; t += 2) {
            const bool last = (t == nt - 2);
            const char* a1 = cA + (size_t)(t + 1) * kstep;
            const char* a2 = last ? nA : cA + (size_t)(t + 2) * kstep; const char* b2 = last ? nB : cB + (size_t)(t + 2) * kstep;
            const char* a3 = a2 + kstep; const char* b3 = b2 + kstep;
            PG8_LDB(B0, 0, 0); PG8_LDB(B1, 0, 1); PG8_SCHED; PG8_LDA(At, 0, 0); PG8_STAGE(PG8_SA(1, 1), a1 + hstepA, voffA);
            PG8_WAIT_V(8); PG8_WAIT_L(0); PG8_BAR; PG8_MMA(0, 0, At, B0); PG8_MMA(0, 1, At, B1); PG8_BAR; PG8_SCHED;
            PG8_LDA(At, 0, 1); PG8_STAGE(PG8_SB(0, 0), b2, voffB); PG8_STAGE(PG8_SB(0, 1), b2 + hstepB, voffB); PG8_STAGE(PG8_SA(0, 0), a2, voffA);
            PG8_WAIT_V(8); PG8_WAIT_L(0); PG8_BAR; PG8_MMA(1, 0, At, B0); PG8_MMA(1, 1, At, B1); PG8_BAR; PG8_SCHED;
            PG8_LDB(B0, 1, 0); PG8_LDB(B1, 1, 1); PG8_SCHED; PG8_LDA(At, 1, 0); PG8_STAGE(PG8_SA(0, 1), a2 + hstepA, voffA);
            PG8_WAIT_V(8); PG8_WAIT_L(0); PG8_BAR; PG8_MMA(0, 0, At, B0); PG8_MMA(0, 1, At, B1); PG8_BAR; PG8_SCHED;
            PG8_LDA(At, 1, 1); PG8_STAGE(PG8_SB(1, 0), b3, voffB); PG8_STAGE(PG8_SB(1, 1), b3 + hstepB, voffB); PG8_STAGE(PG8_SA(1, 0), a3, voffA);
            PG8_WAIT_V(8); PG8_WAIT_L(0); PG8_BAR; PG8_MMA(1, 0, At, B0); PG8_MMA(1, 1, At, B1); PG8_BAR; PG8_SCHED;
        }
        if (wr == 0) PG8_BAR;
        E(acc, cur, wr, wc, fr, fq);
        if (!has_next) break;
#pragma unroll
        for (int a = 0; a < 2; ++a)
#pragma unroll
            for (int b = 0; b < 2; ++b)
#pragma unroll
                for (int m = 0; m < 4; ++m)
#pragma unroll
                    for (int n = 0; n < 2; ++n) acc[a][b][m][n] = (f32x4){0.f, 0.f, 0.f, 0.f};
        cur = nxt; cA = nA; cB = nB; ++ui;
        if (wr == 1) PG8_BAR;
    }
    PG8_WAIT_V(0);
    PG8_BAR;
#undef PG8_SA
#undef PG8_SB
#undef PG8_STAGE
#undef PG8_LDA
#undef PG8_LDB
#undef PG8_MMA
#undef PG8_WAIT_V
#undef PG8_WAIT_L
#undef PG8_BAR
#undef PG8_SCHED
}
}

__device__ __forceinline__ void ssq_add_rows(float* base  , const float (&ss)[2][4], int fr, int fq) {
#pragma unroll
    for (int ai = 0; ai < 2; ++ai) { float t[4];
#pragma unroll
        for (int m = 0; m < 4; ++m) { t[m] = ss[ai][m]; t[m] += swz_xor<16>(t[m]); t[m] = sum_x32(t[m]); }
        const float v = fq == 0 ? t[0] : fq == 1 ? t[1] : fq == 2 ? t[2] : t[3];
        atomicAdd(base + ai * 128 + fq * 16 + fr, v); }
}
template <int MODE> struct EpiBF {
    bf16_t* O; int ldc; const float* rs; const float* ssq_in; float inv_n; float* ssq_a; float* ssq_b;
    const f32x2* cs64; const f32x2* cs32; const f32x2* cs16;
    __device__ __forceinline__ void operator()(const f32x4 (&acc)[2][2][4][2], const pg8::Unit& u, int wr, int wc, int fr, int fq) const {
        asm volatile("" : "+v"(fr), "+v"(fq));
        const int row0 = u.pm * 256 + wr * 64 + fr;
        float sc[2][4];
#pragma unroll
        for (int ai = 0; ai < 2; ++ai)
#pragma unroll
            for (int m = 0; m < 4; ++m) sc[ai][m] = (MODE == 1 || MODE == 2 || MODE == 3) ? ssq_in[row0 + ai * 128 + m * 16] : rs[row0 + ai * 128 + m * 16];
        if (MODE == 1 || MODE == 2 || MODE == 3) {
#pragma unroll
            for (int ai = 0; ai < 2; ++ai)
#pragma unroll
                for (int m = 0; m < 4; ++m) sc[ai][m] = 1.0f / sqrtf(sc[ai][m] * inv_n + EPS);
        }
        float ss[2][4] = {{0.f, 0.f, 0.f, 0.f}, {0.f, 0.f, 0.f, 0.f}};
        const bool do_ss = (MODE == 0) && u.pn < 3 && ssq_a != nullptr;
#pragma unroll
        for (int bj = 0; bj < 2; ++bj) {
            const int colb = u.pn * 256 + bj * 128 + wc * 32, col = colb + 8 * fq;
            bf16_t* dst = O; int dld = ldc, dcol = col;
            if (MODE == 3) {
                unsigned char* wsb = (unsigned char*)O - WS_H;
                if (u.pn == 4) { dst = (bf16_t*)(wsb + (bj == 0 ? WS_KC : WS_VC)) + (size_t)(wc >> 1) * T * 64; dld = 64; dcol = (wc & 1) * 32 + 8 * fq; }
                else if (u.pn >= 8 && u.pn < 14) { const int hd = u.pn * 2 + bj - (u.pn < 11 ? 16 : 22); dst = (bf16_t*)(wsb + (u.pn < 11 ? WS_KD : WS_VD)) + (size_t)hd * T * 128; dld = 128; dcol = wc * 32 + 8 * fq; }
            }
            const f32x2* tb = nullptr; int nf = 0, i0 = 4 * fq; bool lrope = true;
            if (MODE == 0) {
                if (u.pn == 3 && bj == 0 && wc < 2) { tb = cs64; nf = 32; i0 = wc * 16 + 4 * fq; }
                else if (u.pn >= 4 && u.pn < 12 && wc == 0) { tb = cs32; nf = 16; }
            } else if (MODE == 1) {
                const int d = colb % 192; if (d >= 128) { tb = cs64; nf = 32; i0 = ((d - 128) >> 1) + 4 * fq; }
            } else if (MODE == 3) {
                if ((u.pn < 4 || (u.pn == 4 && bj == 0)) && (wc & 1) == 0) { tb = cs16; nf = 8; lrope = fq < 2; if (!lrope) i0 = 0; }
                else if (u.pn >= 5 && u.pn < 11 && wc == 0) { tb = cs32; nf = 16; }
            }
            if (tb != nullptr) {
#pragma unroll
                for (int h4 = 0; h4 < 4; ++h4) {
                    const int ai = h4 >> 1, mb = (h4 & 1) * 2;
                    f32x4 t0[2], t1[2];
#pragma unroll
                    for (int mm = 0; mm < 2; ++mm) { const int pos = (row0 + ai * 128 + (mb + mm) * 16) & (SEQ - 1); const f32x4* tp = (const f32x4*)(tb + pos * nf + i0); t0[mm] = tp[0]; t1[mm] = tp[1]; }
#pragma unroll
                    for (int mm = 0; mm < 2; ++mm) { const int m = mb + mm;
                        const f32x4 v0 = acc[ai][bj][m][0] * sc[ai][m], v1 = acc[ai][bj][m][1] * sc[ai][m]; const f32x4 a = t0[mm], b = t1[mm];
                        f32x4 r0, r1;
                        r0.x = v0.x * a.x - v0.y * a.y; r0.y = v0.x * a.y + v0.y * a.x; r0.z = v0.z * a.z - v0.w * a.w; r0.w = v0.z * a.w + v0.w * a.z;
                        r1.x = v1.x * b.x - v1.y * b.y; r1.y = v1.x * b.y + v1.y * b.x; r1.z = v1.z * b.z - v1.w * b.w; r1.w = v1.z * b.w + v1.w * b.z;
                        if (!lrope) { r0 = v0; r1 = v1; }
                        u32x4 w; w.x = cvt_pk_bf16(r0.x, r0.y); w.y = cvt_pk_bf16(r0.z, r0.w); w.z = cvt_pk_bf16(r1.x, r1.y); w.w = cvt_pk_bf16(r1.z, r1.w);
                        *(u32x4*)(dst + (size_t)(row0 + ai * 128 + m * 16) * dld + dcol) = w;
                    }
                }
            } else {
#pragma unroll
                for (int ai = 0; ai < 2; ++ai)
#pragma unroll
                    for (int m = 0; m < 4; ++m) {
                        const f32x4 v0 = acc[ai][bj][m][0] * sc[ai][m], v1 = acc[ai][bj][m][1] * sc[ai][m];
                        if (MODE == 0) ss[ai][m] += ((v0.x * v0.x + v0.y * v0.y) + (v0.z * v0.z + v0.w * v0.w)) + ((v1.x * v1.x + v1.y * v1.y) + (v1.z * v1.z + v1.w * v1.w));
                        u32x4 w; w.x = cvt_pk_bf16(v0.x, v0.y); w.y = cvt_pk_bf16(v0.z, v0.w); w.z = cvt_pk_bf16(v1.x, v1.y); w.w = cvt_pk_bf16(v1.z, v1.w);
                        *(u32x4*)(dst + (size_t)(row0 + ai * 128 + m * 16) * dld + dcol) = w;
                    }
            }
        }
        if (do_ss) ssq_add_rows((u.pn < 2 ? ssq_a : ssq_b) + u.pm * 256 + wr * 64, ss, fr, fq);
    }
};
template <bool BB, bool WF> struct EpiRes {
    const void* base; float* out; bf16_t* ob; int ldc; float* ssq;
    __device__ __forceinline__ void operator()(const f32x4 (&acc)[2][2][4][2], const pg8::Unit& u, int wr, int wc, int fr, int fq) const {
        asm volatile("" : "+v"(fr), "+v"(fq));
        const int row0 = u.pm * 256 + wr * 64 + fr, col0 = u.pn * 256 + wc * 32 + 8 * fq;
        float ssv[2][4];
#pragma unroll
        for (int h2 = 0; h2 < 4; ++h2) {
            const int ai = h2 >> 1, mb = (h2 & 1) * 2;
            f32x4 pre[2][2][2];
#pragma unroll
            for (int mm = 0; mm < 2; ++mm)
#pragma unroll
                for (int bj = 0; bj < 2; ++bj) {
                    const size_t off = (size_t)(row0 + ai * 128 + (mb + mm) * 16) * ldc + col0 + bj * 128;
                    if (BB) { const u32x4 w = *(const u32x4*)((const bf16_t*)base + off);
                        pre[mm][bj][0] = (f32x4){__uint_as_float(w.x << 16), __uint_as_float(w.x & 0xffff0000u), __uint_as_float(w.y << 16), __uint_as_float(w.y & 0xffff0000u)};
                        pre[mm][bj][1] = (f32x4){__uint_as_float(w.z << 16), __uint_as_float(w.z & 0xffff0000u), __uint_as_float(w.w << 16), __uint_as_float(w.w & 0xffff0000u)}; }
                    else { const float* p = (const float*)base + off; pre[mm][bj][0] = *(const f32x4*)p; pre[mm][bj][1] = *(const f32x4*)(p + 4); } }
#pragma unroll
            for (int mm = 0; mm < 2; ++mm) {
                const int m = mb + mm, row = row0 + ai * 128 + m * 16; float ss = 0.f;
#pragma unroll
                for (int bj = 0; bj < 2; ++bj) {
                    const size_t off = (size_t)row * ldc + col0 + bj * 128;
                    const f32x4 o0 = pre[mm][bj][0] + acc[ai][bj][m][0], o1 = pre[mm][bj][1] + acc[ai][bj][m][1];
                    if (WF) { *(f32x4*)(out + off) = o0; *(f32x4*)(out + off + 4) = o1; }
                    ss += ((o0.x * o0.x + o0.y * o0.y) + (o0.z * o0.z + o0.w * o0.w)) + ((o1.x * o1.x + o1.y * o1.y) + (o1.z * o1.z + o1.w * o1.w));
                    if (ob) { u32x4 w; w.x = cvt_pk_bf16(o0.x, o0.y); w.y = cvt_pk_bf16(o0.z, o0.w); w.z = cvt_pk_bf16(o1.x, o1.y); w.w = cvt_pk_bf16(o1.z, o1.w); *(u32x4*)(ob + off) = w; }
                }
                ssv[ai][m] = ss;
            }
        }
        if (ssq) ssq_add_rows(ssq + u.pm * 256 + wr * 64, ssv, fr, fq);
    }
};

struct EpiFinal {
    const bf16_t* base; float* out; int ldc; float* ssq; unsigned* cnt; const float* g;
    __device__ __forceinline__ void operator()(f32x4 (&acc)[2][2][4][2], const pg8::Unit& u, int wr, int wc, int fr, int fq) const {
        asm volatile("" : "+v"(fr), "+v"(fq));
        const int row0 = u.pm * 256 + wr * 64 + fr, col0 = u.pn * 256 + wc * 32 + 8 * fq;
        float ssv[2][4];
#pragma unroll
        for (int h2 = 0; h2 < 4; ++h2) {
            const int ai = h2 >> 1, mb = (h2 & 1) * 2;
            u32x4 pre[2][2];
#pragma unroll
            for (int mm = 0; mm < 2; ++mm)
#pragma unroll
                for (int bj = 0; bj < 2; ++bj) pre[mm][bj] = *(const u32x4*)(base + (size_t)(row0 + ai * 128 + (mb + mm) * 16) * ldc + col0 + bj * 128);
#pragma unroll
            for (int mm = 0; mm < 2; ++mm) {
                const int m = mb + mm, row = row0 + ai * 128 + m * 16; float ss = 0.f;
#pragma unroll
                for (int bj = 0; bj < 2; ++bj) {
                    const u32x4 w = pre[mm][bj];
                    const f32x4 o0 = (f32x4){__uint_as_float(w.x << 16), __uint_as_float(w.x & 0xffff0000u), __uint_as_float(w.y << 16), __uint_as_float(w.y & 0xffff0000u)} + acc[ai][bj][m][0];
                    const f32x4 o1 = (f32x4){__uint_as_float(w.z << 16), __uint_as_float(w.z & 0xffff0000u), __uint_as_float(w.w << 16), __uint_as_float(w.w & 0xffff0000u)} + acc[ai][bj][m][1];
                    acc[ai][bj][m][0] = o0; acc[ai][bj][m][1] = o1;
                    ss += ((o0.x * o0.x + o0.y * o0.y) + (o0.z * o0.z + o0.w * o0.w)) + ((o1.x * o1.x + o1.y * o1.y) + (o1.z * o1.z + o1.w * o1.w));
                }
                ssv[ai][m] = ss;
            }
        }
        ssq_add_rows(ssq + u.pm * 256 + wr * 64, ssv, fr, fq);
        asm volatile("s_waitcnt vmcnt(0)" ::: "memory");
        __builtin_amdgcn_s_barrier();
        if (wr == 0 && wc == 0) {
            unsigned* cw = cnt + 64 * u.pm;
            if (fr == 0 && fq == 0) __hip_atomic_fetch_add(cw, 1u, __ATOMIC_RELAXED, __HIP_MEMORY_SCOPE_AGENT);
            unsigned sp = 0; while (__hip_atomic_load(cw, __ATOMIC_RELAXED, __HIP_MEMORY_SCOPE_AGENT) < 8u && ++sp < (1u << 22)) __builtin_amdgcn_s_sleep(2);
        }
        __builtin_amdgcn_s_barrier();
        float rsv[2][4];
#pragma unroll
        for (int ai = 0; ai < 2; ++ai)
#pragma unroll
            for (int m = 0; m < 4; ++m) rsv[ai][m] = __hip_atomic_load(ssq + row0 + ai * 128 + m * 16, __ATOMIC_RELAXED, __HIP_MEMORY_SCOPE_AGENT);
#pragma unroll
        for (int ai = 0; ai < 2; ++ai)
#pragma unroll
            for (int m = 0; m < 4; ++m) rsv[ai][m] = 1.0f / sqrtf(rsv[ai][m] * (1.0f / DM) + EPS);
#pragma unroll
        for (int bj = 0; bj < 2; ++bj) {
            const f32x4 g0 = *(const f32x4*)(g + col0 + bj * 128), g1 = *(const f32x4*)(g + col0 + bj * 128 + 4);
#pragma unroll
            for (int ai = 0; ai < 2; ++ai)
#pragma unroll
                for (int m = 0; m < 4; ++m) {
                    const size_t off = (size_t)(row0 + ai * 128 + m * 16) * ldc + col0 + bj * 128; const float r = rsv[ai][m];
                    *(f32x4*)(out + off) = acc[ai][bj][m][0] * r * g0; *(f32x4*)(out + off + 4) = acc[ai][bj][m][1] * r * g1;
                }
        }
    }
};

struct TailUnits { int c, G, n, pn; __device__ __forceinline__ bool next(int i, pg8::Unit& u) const { const int pm = c + i * G; if (pm >= n) return false; u.pm = pm; u.pn = pn; return true; } };
template <class Epi, class Sched>
__device__ __forceinline__ void run_gemm_s(LAS unsigned char* lds, const bf16_t* A, int lda, const bf16_t* Bt, int M, int N, int K, const Epi& E, const Sched& S, const int wave_s) {
    pg8::Gemm g{A, Bt, M, N, K, lda};
    pg8::gemm_phase<Epi, Sched>(lds, g, S, E, wave_s);
}
template <class Epi>
__device__ __forceinline__ void run_gemm(LAS unsigned char* lds, const bf16_t* A, int lda, const bf16_t* Bt, int M, int N, int K, const Epi& E, int coff, const int wave_s, const int wgm = 2) {
    pg8::Gemm g{A, Bt, M, N, K, lda}; pg8::StaticOrder S; int cc_ = (int)blockIdx.x + coff; if (cc_ >= (int)gridDim.x) cc_ -= (int)gridDim.x; S.init(M, N, (int)gridDim.x, cc_, wgm);
    pg8::gemm_phase<Epi, pg8::StaticOrder>(lds, g, S, E, wave_s);
}

namespace fa {
typedef float f32x16 __attribute__((ext_vector_type(16)));
typedef short s16x4 __attribute__((ext_vector_type(4)));
constexpr int KMAXB = 24576, VMAXB = 16384;
constexpr int OFF_V = 3 * KMAXB, OFF_SCR = OFF_V + 2 * VMAXB, OFF_STG = 0, OFF_Q = OFF_SCR + 8 * 256, LDS_NEED = OFF_Q + 16;
constexpr float THR = 8.f;
__device__ __forceinline__ s16x4 vtr(const LAS unsigned char* p) { return __builtin_bit_cast(s16x4, __builtin_amdgcn_ds_read_tr16_b64_v4i16((LAS s16x4*)p)); }
__device__ __forceinline__ float silu(float g) { return g * __builtin_amdgcn_rcpf(1.0f + __builtin_amdgcn_exp2f(-1.4426950408889634f * g)); }

template <int MODE>
__device__ __forceinline__ void attn_item(LAS unsigned char* lds, unsigned char* ws, const float* sinks, int item, const int wave) {
    constexpr int DQK = MODE == 0 ? 192 : MODE == 3 ? 64 : 128, DV = MODE == 3 ? 64 : 128;
    constexpr int NKC = DQK / 64, NVC = DV / 64, ND0 = DQK / 16, NDV = DV / 32;
    constexpr int LDH = (MODE <= 2) ? LDH0 : LDH1;
    constexpr bool CAUSAL = (MODE == 0 || MODE == 1), NOMASK = (MODE == 2 || MODE == 5);
    constexpr unsigned WD = CAUSAL ? 0x7fffffffu : (MODE == 3 ? 127u : 128u);
    constexpr float SCALE = MODE == 0 ? 0.07216878364870322f : MODE == 3 ? 0.125f : 0.08838834764831845f;
    constexpr float C2 = SCALE * 1.4426950408889634f;
    int tid = wave * 64 + lane_id(); asm volatile("" : "+v"(tid));
    const int lane = tid & 63, c = lane & 31, hi = lane >> 5;
    bf16_t* H = (bf16_t*)(ws + WS_H);
    const bf16_t* qrow; const bf16_t* kbase; const bf16_t* k2base = nullptr; const bf16_t* vbase; long kstride, vstride, k2stride = 0;
    int qpos, kt_first, nt, blk = 0; long tok0, tokstep = 1; int ycol = 0, hh, pat = 0;
    if (MODE == 0 || MODE == 1) {
        const int qt = 15 - (item >> 5), bh = item & 31, b = bh >> 3; hh = bh & 7; blk = qt;
        tok0 = (long)b * SEQ + 256 * qt + 32 * wave; qpos = 256 * qt + 32 * wave; kt_first = 0; nt = 4 * (qt + 1);
        if (MODE == 0) {
            qrow = (const bf16_t*)sinks + (tok0 + c) * 1536 + hh * 192;
            kbase = (const bf16_t*)(ws + WS_KVA) + (long)b * SEQ * 2048 + hh * 256; kstride = 2048; vbase = kbase + 128; vstride = 2048;
            k2base = H + (long)b * SEQ * LDH0 + E_KPE; k2stride = LDH0; ycol = E_G + hh * 128;
        } else {
            qrow = H + (tok0 + c) * LDH0 + E_QB + hh * 128; kbase = H + (long)b * SEQ * LDH0 + E_KB + hh * 128; vbase = H + (long)b * SEQ * LDH0 + E_VB + hh * 128;
            kstride = vstride = LDH0; ycol = E_G + 1024 + hh * 128;
        }
    } else if (MODE == 2 || MODE == 5) {
        const int b = item >> 6, qt = item & 15; hh = (item >> 4) & 3;
        tok0 = (long)b * SEQ + 256 * qt + 32 * wave; qpos = 0; kt_first = 0; nt = 4;
        const bf16_t* MKV = (const bf16_t*)(ws + (MODE == 2 ? WS_MKVE : WS_MKVO));
        qrow = H + (tok0 + c) * LDH + (MODE == 2 ? E_QM : O_QM) + hh * 128;
        kbase = MKV + (long)b * NMEM * 1024 + hh * 128; vbase = kbase + 512; kstride = vstride = 1024;
        ycol = (MODE == 2 ? E_G + 2048 : O_G + 1792) + hh * 128;
    } else if (MODE == 3) {
        const int b = item >> 8, kvh = (item >> 7) & 1, tt = item & 127, t0 = 32 * tt; hh = kvh * 8 + wave;
        tok0 = (long)b * SEQ + t0; qpos = t0; kt_first = (t0 > 127 ? t0 - 127 : 0) & ~63; nt = ((t0 + 31) >> 6) - (kt_first >> 6) + 1;
        qrow = H + (tok0 + c) * LDH1 + O_QC + hh * 64; kbase = (const bf16_t*)(ws + WS_KC) + ((long)kvh * T + (long)b * SEQ) * 64; vbase = (const bf16_t*)(ws + WS_VC) + ((long)kvh * T + (long)b * SEQ) * 64;
        kstride = vstride = 64; ycol = O_G + hh * 64;
    } else {
        pat = item / 384; const int jj = item - pat * 384; hh = jj % 6; const int rest = jj / 6, b = rest >> 4;
        int r, qt, d;
        if (pat == 0) { r = 0; qt = rest & 15; d = 1; } else if (pat == 1) { r = (rest >> 2) & 3; qt = rest & 3; d = 4; } else { r = rest & 15; qt = 0; d = 16; }
        const long base = (long)b * SEQ + r; qpos = 256 * qt + 32 * wave; tokstep = d; tok0 = base + (long)d * qpos;
        kt_first = qt > 0 ? 256 * qt - 128 : 0; nt = 4 * (qt + 1) - (kt_first >> 6);
        qrow = H + (tok0 + (long)d * c) * LDH1 + O_QD + hh * 128; kbase = (const bf16_t*)(ws + WS_KD) + ((long)hh * T + base) * 128; vbase = (const bf16_t*)(ws + WS_VD) + ((long)hh * T + base) * 128;
        kstride = vstride = (long)d * 128;
    }
    bf16x8 qf[ND0];
#pragma unroll
    for (int d0 = 0; d0 < ND0; ++d0) qf[d0] = *(const bf16x8*)(qrow + 16 * d0 + 8 * hi);
    unsigned selmask = 0;
    if (MODE == 1 && blk > 0) {
        const float* km = (const float*)(ws + WS_KMEAN) + ((size_t)((item & 31) * 16 + (c & 15))) * 128;
        f32x16 G = {0.f, 0.f, 0.f, 0.f, 0.f, 0.f, 0.f, 0.f, 0.f, 0.f, 0.f, 0.f, 0.f, 0.f, 0.f, 0.f};
#pragma unroll
        for (int d0 = 0; d0 < 8; ++d0) {
            f32x4 a = *(const f32x4*)(km + 16 * d0 + 8 * hi), b = *(const f32x4*)(km + 16 * d0 + 8 * hi + 4);
            if (c >= 16) { a = (f32x4){0.f, 0.f, 0.f, 0.f}; b = a; }
            u32x4 wh; wh.x = cvt_pk_bf16(a.x, a.y); wh.y = cvt_pk_bf16(a.z, a.w); wh.z = cvt_pk_bf16(b.x, b.y); wh.w = cvt_pk_bf16(b.z, b.w);
            f32x4 ra, rb;
            ra.x = a.x - __uint_as_float(wh.x << 16); ra.y = a.y - __uint_as_float(wh.x & 0xffff0000u); ra.z = a.z - __uint_as_float(wh.y << 16); ra.w = a.w - __uint_as_float(wh.y & 0xffff0000u);
            rb.x = b.x - __uint_as_float(wh.z << 16); rb.y = b.y - __uint_as_float(wh.z & 0xffff0000u); rb.z = b.z - __uint_as_float(wh.w << 16); rb.w = b.w - __uint_as_float(wh.w & 0xffff0000u);
            u32x4 wl; wl.x = cvt_pk_bf16(ra.x, ra.y); wl.y = cvt_pk_bf16(ra.z, ra.w); wl.z = cvt_pk_bf16(rb.x, rb.y); wl.w = cvt_pk_bf16(rb.z, rb.w);
            G = __builtin_amdgcn_mfma_f32_32x32x16_bf16(__builtin_bit_cast(bf16x8, wh), qf[d0], G, 0, 0, 0);
            G = __builtin_amdgcn_mfma_f32_32x32x16_bf16(__builtin_bit_cast(bf16x8, wl), qf[d0], G, 0, 0, 0);
        }
        float gv[16];
#pragma unroll
        for (int r = 0; r < 8; ++r) { const float own = G[r], oth = xchg_x32(own); const int n0 = (r & 3) + 8 * (r >> 2);
            gv[n0] = hi == 0 ? own : oth; gv[n0 + 4] = hi == 0 ? oth : own; }
        unsigned used = 0;
#pragma unroll
        for (int k = 0; k < 3; ++k) { int best = -1; float bv = -INFINITY;
#pragma unroll
            for (int n = 0; n < 16; ++n) if (!((used >> n) & 1u) && n < blk && (best < 0 || gv[n] > bv)) { best = n; bv = gv[n]; }
            if (best >= 0) used |= 1u << best; }
        selmask = used;
    }
    LAS unsigned char* scrb = lds + OFF_SCR + wave * 256; LAS float* al = (LAS float*)scrb; LAS float* li = al + 32; const LAS float* alh = al + 4 * hi; const LAS float* lih = li + 4 * hi;
    const int kk = wave * 8 + (lane & 7), cc = lane >> 3;
    const int kwr = cc * 1024 + kk * 16;
    int kvr, vwr; long vgo;
    if (DV == 128) { kvr = tid >> 4; const int c16 = tid & 15; vwr = kvr * 256 + ((((c16 >> 2) ^ (kvr & 3))) << 6) + (c16 & 3) * 16; vgo = 8 * c16; }
    else { kvr = tid >> 3; const int c8 = tid & 7; vwr = kvr * 128 + ((((c8 >> 2) ^ ((kvr >> 1) & 1))) << 6) + (c8 & 3) * 16; vgo = 8 * c8; }
    const int krd = hi * 1024 + c * 16;
    const int q4 = (lane & 15) >> 2, p4 = lane & 3, colhalf = (lane >> 4) & 1;
    int vrd, vq[NDV];
    if (DV == 128) { vrd = (4 * hi + q4) * 256 + 32 * colhalf + 8 * p4;
#pragma unroll
        for (int d0 = 0; d0 < NDV; ++d0) vq[d0] = (d0 ^ q4) << 6; }
    else { vrd = (4 * hi + q4) * 128 + 32 * colhalf + 8 * p4;
#pragma unroll
        for (int d0 = 0; d0 < NDV; ++d0) vq[d0] = (d0 ^ ((q4 >> 1) & 1)) << 6; }
    constexpr int VS = DV * 2 * 16, VH = DV * 2 * 8;
    u32x4 kst[NKC], vst[NVC];
    f32x16 o[NDV];
#pragma unroll
    for (int d0 = 0; d0 < NDV; ++d0) o[d0] = (f32x16){0.f, 0.f, 0.f, 0.f, 0.f, 0.f, 0.f, 0.f, 0.f, 0.f, 0.f, 0.f, 0.f, 0.f, 0.f, 0.f};
    float m_reg = -1e30f, l_reg = 0.f;
    constexpr bool SKIPMODE = (MODE == 3 || MODE == 4);
    if constexpr (SKIPMODE) {
#define FA_GLOAD(t) do { const long j0_ = kt_first + 64 * (t); \
        _Pragma("unroll") for (int i_ = 0; i_ < NKC; ++i_) { \
            if (MODE == 0 && i_ == 2) kst[i_] = *(const u32x4*)(k2base + (j0_ + kk) * k2stride + 8 * cc); \
            else kst[i_] = *(const u32x4*)(kbase + (j0_ + kk) * kstride + 8 * (8 * i_ + cc)); } \
        _Pragma("unroll") for (int i_ = 0; i_ < NVC; ++i_) vst[i_] = *(const u32x4*)(vbase + (j0_ + kvr + 32 * i_) * vstride + vgo); } while (0)
#define FA_LWRITE(bf) do { LAS unsigned char* kb_ = lds + (bf) * KMAXB; LAS unsigned char* vb_ = lds + OFF_V + (bf) * VMAXB; \
        _Pragma("unroll") for (int i_ = 0; i_ < NKC; ++i_) *(LAS u32x4*)(kb_ + kwr + i_ * 8192) = kst[i_]; \
        _Pragma("unroll") for (int i_ = 0; i_ < NVC; ++i_) *(LAS u32x4*)(vb_ + vwr + i_ * 8192) = vst[i_]; } while (0)
    FA_GLOAD(0); FA_LWRITE(0);
    __syncthreads();
    for (int t = 0; t < nt; ++t) {
        const int kt0 = kt_first + 64 * t;
        if (t + 1 < nt) FA_GLOAD(t + 1);
        bool act = true, rowmask = false, bandmask = false;
        if (MODE == 1 && t < 4 * blk) { const int n = t >> 2; const bool mine = (selmask >> n) & 1u; act = __ballot(mine) != 0ull; rowmask = true; }
        else if (!NOMASK) {
            act = kt0 <= qpos + 31 && (CAUSAL || kt0 + 63 + (int)WD >= qpos);
            bandmask = !(kt0 + 63 <= qpos && (CAUSAL || kt0 + (int)WD >= qpos + 31));
        }
        if (act) {
            LAS unsigned char* kb = lds + (t & 1) * KMAXB; LAS unsigned char* vb = lds + OFF_V + (t & 1) * VMAXB;
            f32x16 p0 = {0.f, 0.f, 0.f, 0.f, 0.f, 0.f, 0.f, 0.f, 0.f, 0.f, 0.f, 0.f, 0.f, 0.f, 0.f, 0.f}, p1 = p0;
            {
                bf16x8 k0[ND0], k1[ND0];
#pragma unroll
                for (int d0 = 0; d0 < ND0; ++d0) { k0[d0] = *(const LAS bf16x8*)(kb + krd + d0 * 2048); k1[d0] = *(const LAS bf16x8*)(kb + krd + d0 * 2048 + 512); }
#pragma unroll
                for (int d0 = 0; d0 < ND0; ++d0) { p0 = __builtin_amdgcn_mfma_f32_32x32x16_bf16(k0[d0], qf[d0], p0, 0, 0, 0); p1 = __builtin_amdgcn_mfma_f32_32x32x16_bf16(k1[d0], qf[d0], p1, 0, 0, 0); }
                __builtin_amdgcn_sched_group_barrier(0x100, 4, 0);
#pragma unroll
                for (int d0 = 0; d0 < ND0; ++d0) { if (d0 + 2 < ND0) __builtin_amdgcn_sched_group_barrier(0x100, 2, 0); __builtin_amdgcn_sched_group_barrier(0x008, 2, 0); }
            }
            if (rowmask) { if (!((selmask >> (t >> 2)) & 1u)) {
#pragma unroll
                for (int r = 0; r < 16; ++r) { p0[r] = -INFINITY; p1[r] = -INFINITY; } } }
            if (bandmask) { const int dq = qpos + c - kt0 - 4 * hi;
#pragma unroll
                for (int r = 0; r < 16; ++r) { const int cr = (r & 3) + 8 * (r >> 2);
                    if ((unsigned)(dq - cr) > WD) p0[r] = -INFINITY;
                    if ((unsigned)(dq - cr - 32) > WD) p1[r] = -INFINITY; } }
            float pmax = p0[0];
#pragma unroll
            for (int r = 1; r < 16; ++r) pmax = fmaxf(pmax, p0[r]);
#pragma unroll
            for (int r = 0; r < 16; ++r) pmax = fmaxf(pmax, p1[r]);
            pmax = max_x32(pmax);
            if (!__all((pmax - m_reg) * SCALE <= THR)) {
                const float mn = fmaxf(m_reg, pmax), alpha = __builtin_amdgcn_exp2f((m_reg - mn) * C2); m_reg = mn; l_reg *= alpha;
                if (hi == 0) al[c] = alpha;
                asm volatile("s_waitcnt lgkmcnt(0)" ::: "memory");
#pragma unroll
                for (int r = 0; r < 16; ++r) { const float f = alh[(r & 3) + 8 * (r >> 2)];
#pragma unroll
                    for (int d0 = 0; d0 < NDV; ++d0) o[d0][r] *= f; }
                asm volatile("s_waitcnt lgkmcnt(0)" ::: "memory");
            }
            const float mnl = -m_reg * C2; float ps = 0.f;
#pragma unroll
            for (int r = 0; r < 16; ++r) { p0[r] = __builtin_amdgcn_exp2f(fmaf(p0[r], C2, mnl)); p1[r] = __builtin_amdgcn_exp2f(fmaf(p1[r], C2, mnl)); ps += p0[r] + p1[r]; }
            l_reg += ps;
            bf16x8 pa[4];
#pragma unroll
            for (int s = 0; s < 4; ++s) { u32x4 w;
                if (s < 2) { w.x = cvt_pk_bf16(p0[8 * s + 0], p0[8 * s + 1]); w.y = cvt_pk_bf16(p0[8 * s + 2], p0[8 * s + 3]); w.z = cvt_pk_bf16(p0[8 * s + 4], p0[8 * s + 5]); w.w = cvt_pk_bf16(p0[8 * s + 6], p0[8 * s + 7]); }
                else { const int s2 = s - 2; w.x = cvt_pk_bf16(p1[8 * s2 + 0], p1[8 * s2 + 1]); w.y = cvt_pk_bf16(p1[8 * s2 + 2], p1[8 * s2 + 3]); w.z = cvt_pk_bf16(p1[8 * s2 + 4], p1[8 * s2 + 5]); w.w = cvt_pk_bf16(p1[8 * s2 + 6], p1[8 * s2 + 7]); }
                pa[s] = __builtin_bit_cast(bf16x8, w); }
            {
                s16x4 lo[4 * NDV], hv[4 * NDV];
#pragma unroll
                for (int s = 0; s < 4; ++s)
#pragma unroll
                    for (int d0 = 0; d0 < NDV; ++d0) { lo[s * NDV + d0] = vtr(vb + vrd + vq[d0] + s * VS); hv[s * NDV + d0] = vtr(vb + vrd + vq[d0] + s * VS + VH); }
#pragma unroll
                for (int s = 0; s < 4; ++s)
#pragma unroll
                    for (int d0 = 0; d0 < NDV; ++d0) { const s16x4 a_ = lo[s * NDV + d0], b_ = hv[s * NDV + d0];
                        const bf16x8 vf = {a_[0], a_[1], a_[2], a_[3], b_[0], b_[1], b_[2], b_[3]};
                        o[d0] = __builtin_amdgcn_mfma_f32_32x32x16_bf16(pa[s], vf, o[d0], 0, 0, 0); }
                __builtin_amdgcn_sched_group_barrier(0x100, 4, 1);
#pragma unroll
                for (int i = 0; i < 4 * NDV; ++i) { if (i + 2 < 4 * NDV) __builtin_amdgcn_sched_group_barrier(0x100, 2, 1); __builtin_amdgcn_sched_group_barrier(0x008, 1, 1); }
            }
        }
        if (t + 1 < nt) FA_LWRITE((t + 1) & 1);
        __syncthreads();
    }
#undef FA_GLOAD
#undef FA_LWRITE
    } else {
    unsigned kvo[NKC], vvo[NVC];
#pragma unroll
    for (int i_ = 0; i_ < NKC; ++i_) kvo[i_] = (MODE == 0 && i_ == 2) ? (unsigned)(kk * k2stride + 8 * cc) * 2u : (unsigned)(kk * kstride + 8 * (8 * i_ + cc)) * 2u;
#pragma unroll
    for (int i_ = 0; i_ < NVC; ++i_) vvo[i_] = (unsigned)((kvr + 32 * i_) * vstride + vgo) * 2u;
#define FA_GLOAD_K(t) do { const long j0_ = kt_first + 64 * (t); const char* kb0_ = (const char*)(kbase + j0_ * kstride); const char* kb2_ = (const char*)(k2base + j0_ * k2stride); \
        _Pragma("unroll") for (int i_ = 0; i_ < NKC; ++i_) { \
            if (MODE == 0 && i_ == 2) kst[i_] = *(const u32x4*)(kb2_ + kvo[i_]); \
            else kst[i_] = *(const u32x4*)(kb0_ + kvo[i_]); } } while (0)
#define FA_GLOAD_V(t) do { const long j0_ = kt_first + 64 * (t); const char* vb0_ = (const char*)(vbase + j0_ * vstride); \
        _Pragma("unroll") for (int i_ = 0; i_ < NVC; ++i_) vst[i_] = *(const u32x4*)(vb0_ + vvo[i_]); } while (0)
#define FA_LWRITE_K(kofs) do { LAS unsigned char* kb_ = lds + (kofs); \
        _Pragma("unroll") for (int i_ = 0; i_ < NKC; ++i_) *(LAS u32x4*)(kb_ + kwr + i_ * 8192) = kst[i_]; } while (0)
#define FA_LWRITE_V(bf) do { LAS unsigned char* vb_ = lds + OFF_V + (bf) * VMAXB; \
        _Pragma("unroll") for (int i_ = 0; i_ < NVC; ++i_) *(LAS u32x4*)(vb_ + vwr + i_ * 8192) = vst[i_]; } while (0)
#define FA_QK_H(P, kofs, koff) \
        { int ka_ = (kofs) + (koff) + krd; asm volatile("" : "+v"(ka_)); const LAS unsigned char* kb_ = lds + ka_; bf16x8 kf_[ND0]; \
          P = (f32x16){0.f, 0.f, 0.f, 0.f, 0.f, 0.f, 0.f, 0.f, 0.f, 0.f, 0.f, 0.f, 0.f, 0.f, 0.f, 0.f}; \
          _Pragma("unroll") for (int d0 = 0; d0 < ND0; ++d0) kf_[d0] = *(const LAS bf16x8*)(kb_ + d0 * 2048); \
          _Pragma("unroll") for (int d0 = 0; d0 < ND0; ++d0) P = __builtin_amdgcn_mfma_f32_32x32x16_bf16(kf_[d0], qf[d0], P, 0, 0, 0); }
#define FA_KPRE(kofs, koff) \
        { int ka_ = (kofs) + (koff) + krd; asm volatile("" : "+v"(ka_)); const LAS unsigned char* kb_ = lds + ka_; kpre0 = *(const LAS bf16x8*)(kb_); kpre1 = *(const LAS bf16x8*)(kb_ + 2048); }
#define FA_QK_HP(P, kofs, koff) \
        { int ka_ = (kofs) + (koff) + krd; asm volatile("" : "+v"(ka_)); const LAS unsigned char* kb_ = lds + ka_; bf16x8 kf_[ND0]; kf_[0] = kpre0; kf_[1] = kpre1; \
          P = (f32x16){0.f, 0.f, 0.f, 0.f, 0.f, 0.f, 0.f, 0.f, 0.f, 0.f, 0.f, 0.f, 0.f, 0.f, 0.f, 0.f}; \
          _Pragma("unroll") for (int d0 = 2; d0 < ND0; ++d0) kf_[d0] = *(const LAS bf16x8*)(kb_ + d0 * 2048); \
          _Pragma("unroll") for (int d0 = 0; d0 < ND0; ++d0) P = __builtin_amdgcn_mfma_f32_32x32x16_bf16(kf_[d0], qf[d0], P, 0, 0, 0); }
#define FA_VPRE(bf, s0) \
        { int a0_ = OFF_V + (bf) * VMAXB + (s0) * VS + vrd + vq[0], a1_ = OFF_V + (bf) * VMAXB + (s0) * VS + vrd + vq[1]; asm volatile("" : "+v"(a0_), "+v"(a1_)); \
          vplo0 = vtr(lds + a0_); vphv0 = vtr(lds + a0_ + VH); vplo1 = vtr(lds + a1_); vphv1 = vtr(lds + a1_ + VH); }
#define FA_PV_HP(bf, s0) \
        { s16x4 lo_[2 * NDV], hv_[2 * NDV]; const LAS unsigned char* vbd_[NDV]; \
          _Pragma("unroll") for (int d0 = 0; d0 < NDV; ++d0) { int a_ = OFF_V + (bf) * VMAXB + (s0) * VS + vrd + vq[d0]; asm volatile("" : "+v"(a_)); vbd_[d0] = lds + a_; } \
          lo_[0] = vplo0; hv_[0] = vphv0; lo_[1] = vplo1; hv_[1] = vphv1; \
          _Pragma("unroll") for (int s_ = 0; s_ < 2; ++s_) _Pragma("unroll") for (int d0 = 0; d0 < NDV; ++d0) { if (s_ * NDV + d0 >= 2) { lo_[s_ * NDV + d0] = vtr(vbd_[d0] + s_ * VS); hv_[s_ * NDV + d0] = vtr(vbd_[d0] + s_ * VS + VH); } } \
          _Pragma("unroll") for (int s_ = 0; s_ < 2; ++s_) _Pragma("unroll") for (int d0 = 0; d0 < NDV; ++d0) { const s16x4 a_ = lo_[s_ * NDV + d0], b_ = hv_[s_ * NDV + d0]; \
              const bf16x8 vf_ = {a_[0], a_[1], a_[2], a_[3], b_[0], b_[1], b_[2], b_[3]}; o[d0] = __builtin_amdgcn_mfma_f32_32x32x16_bf16(pa[s_], vf_, o[d0], 0, 0, 0); } }
#define FA_QKP_EXP_SGB \
        { constexpr int NV_ = (50 + ND0 - 1) / ND0, NT_ = (16 + ND0 - 1) / ND0; \
          _Pragma("unroll") for (int d0 = 0; d0 < ND0; ++d0) { if (d0 + 2 < ND0) __builtin_amdgcn_sched_group_barrier(0x100, 1, 0); __builtin_amdgcn_sched_group_barrier(0x008, 1, 0); \
              __builtin_amdgcn_sched_group_barrier(0x002, NV_, 0); __builtin_amdgcn_sched_group_barrier(0x400, NT_, 0); } \
          __builtin_amdgcn_sched_group_barrier(0x100, 4, 0); }
#define FA_PVP_SGB \
        { _Pragma("unroll") for (int i_ = 0; i_ < 2 * NDV; ++i_) { if (i_ + 2 < 2 * NDV) __builtin_amdgcn_sched_group_barrier(0x100, 2, 1); __builtin_amdgcn_sched_group_barrier(0x008, 1, 1); } \
          __builtin_amdgcn_sched_group_barrier(0x100, 2, 1); }
#define FA_QK_SGB \
        { __builtin_amdgcn_sched_group_barrier(0x100, 2, 0); \
          _Pragma("unroll") for (int d0 = 0; d0 < ND0; ++d0) { if (d0 + 2 < ND0) __builtin_amdgcn_sched_group_barrier(0x100, 1, 0); __builtin_amdgcn_sched_group_barrier(0x008, 1, 0); } }
#define FA_QK_EXP_SGB \
        { constexpr int NV_ = (48 + ND0 - 1) / ND0, NT_ = (16 + ND0 - 1) / ND0; \
          __builtin_amdgcn_sched_group_barrier(0x100, 2, 0); \
          _Pragma("unroll") for (int d0 = 0; d0 < ND0; ++d0) { if (d0 + 2 < ND0) __builtin_amdgcn_sched_group_barrier(0x100, 1, 0); __builtin_amdgcn_sched_group_barrier(0x008, 1, 0); \
              __builtin_amdgcn_sched_group_barrier(0x002, NV_, 0); __builtin_amdgcn_sched_group_barrier(0x400, NT_, 0); } }
#define FA_EXP_H(P) \
        { const float mnl_ = -m_reg * C2; float ps_ = 0.f; \
          _Pragma("unroll") for (int r = 0; r < 16; ++r) { P[r] = __builtin_amdgcn_exp2f(fmaf(P[r], C2, mnl_)); ps_ += P[r]; } \
          l_reg += ps_; \
          _Pragma("unroll") for (int s_ = 0; s_ < 2; ++s_) { u32x4 w_; \
              w_.x = cvt_pk_bf16(P[8 * s_ + 0], P[8 * s_ + 1]); w_.y = cvt_pk_bf16(P[8 * s_ + 2], P[8 * s_ + 3]); w_.z = cvt_pk_bf16(P[8 * s_ + 4], P[8 * s_ + 5]); w_.w = cvt_pk_bf16(P[8 * s_ + 6], P[8 * s_ + 7]); pa[s_] = __builtin_bit_cast(bf16x8, w_); } }
#define FA_MASK_H(P, tt, hh) \
        { const int tt_ = (tt); bool rowm_ = false, bandm_ = false; const int kt0_ = kt_first + 64 * tt_; \
          if (MODE == 1 && tt_ < 4 * blk) rowm_ = true; else if (!NOMASK) bandm_ = !(kt0_ + 63 <= qpos && (CAUSAL || kt0_ + (int)WD >= qpos + 31)); \
          if (rowm_) { if (!((selmask >> (tt_ >> 2)) & 1u)) { _Pragma("unroll") for (int r = 0; r < 16; ++r) P[r] = -INFINITY; } } \
          if (bandm_) { const int dq_ = qpos + c - kt0_ - 4 * hi - 32 * (hh); \
              _Pragma("unroll") for (int r = 0; r < 16; ++r) { if ((unsigned)(dq_ - ((r & 3) + 8 * (r >> 2))) > WD) P[r] = -INFINITY; } } }
#define FA_MAX_H(P, PM) \
        { float pm_ = fmaxf(P[0], P[1]); \
          _Pragma("unroll") for (int r = 2; r < 16; r += 2) pm_ = fmaxf(fmaxf(pm_, P[r]), P[r + 1]); \
          auto rr_ = __builtin_amdgcn_permlane32_swap(__float_as_uint(pm_), __float_as_uint(pm_), false, false); PM = fmaxf(__uint_as_float(rr_[0]), __uint_as_float(rr_[1])); }
#define FA_DECIDE(PM) \
        { if (!__all(((PM) - m_reg) * SCALE <= THR)) { \
              const float mn_ = fmaxf(m_reg, (PM)), alpha_ = __builtin_amdgcn_exp2f((m_reg - mn_) * C2); m_reg = mn_; l_reg *= alpha_; \
              if (hi == 0) al[c] = alpha_; \
              asm volatile("s_waitcnt lgkmcnt(0)" ::: "memory"); \
              _Pragma("unroll") for (int r = 0; r < 16; ++r) { const float f_ = alh[(r & 3) + 8 * (r >> 2)]; \
                  _Pragma("unroll") for (int d0 = 0; d0 < NDV; ++d0) o[d0][r] *= f_; } \
              asm volatile("s_waitcnt lgkmcnt(0)" ::: "memory"); } }
#define FA_PV_H(bf, s0) \
        { s16x4 lo_[2 * NDV], hv_[2 * NDV]; const LAS unsigned char* vbd_[NDV]; \
          _Pragma("unroll") for (int d0 = 0; d0 < NDV; ++d0) { int a_ = OFF_V + (bf) * VMAXB + (s0) * VS + vrd + vq[d0]; asm volatile("" : "+v"(a_)); vbd_[d0] = lds + a_; }     \
          _Pragma("unroll") for (int s_ = 0; s_ < 2; ++s_) _Pragma("unroll") for (int d0 = 0; d0 < NDV; ++d0) { lo_[s_ * NDV + d0] = vtr(vbd_[d0] + s_ * VS); hv_[s_ * NDV + d0] = vtr(vbd_[d0] + s_ * VS + VH); } \
          _Pragma("unroll") for (int s_ = 0; s_ < 2; ++s_) _Pragma("unroll") for (int d0 = 0; d0 < NDV; ++d0) { const s16x4 a_ = lo_[s_ * NDV + d0], b_ = hv_[s_ * NDV + d0]; \
              const bf16x8 vf_ = {a_[0], a_[1], a_[2], a_[3], b_[0], b_[1], b_[2], b_[3]}; o[d0] = __builtin_amdgcn_mfma_f32_32x32x16_bf16(pa[s_], vf_, o[d0], 0, 0, 0); } \
          __builtin_amdgcn_sched_group_barrier(0x100, 4, 1); \
          _Pragma("unroll") for (int i_ = 0; i_ < 2 * NDV; ++i_) { if (i_ + 2 < 2 * NDV) __builtin_amdgcn_sched_group_barrier(0x100, 2, 1); __builtin_amdgcn_sched_group_barrier(0x008, 1, 1); } }
    {
        f32x16 pA, pB;
        bf16x8 kpre0, kpre1; s16x4 vplo0, vphv0, vplo1, vphv1;
        FA_GLOAD_K(0); FA_GLOAD_V(0); FA_LWRITE_K(0); FA_LWRITE_V(0);
        if (nt > 1) { FA_GLOAD_K(1); FA_LWRITE_K(KMAXB); }
        __syncthreads();
        { FA_QK_H(pA, 0, 0) FA_QK_SGB }
        float pmA, pmB;
        FA_MASK_H(pA, 0, 0)
        FA_MAX_H(pA, pmA)
        FA_KPRE(0, 512)
        int kc = 0, kn = KMAXB, kw = 2 * KMAXB;
        const int ntw = CAUSAL ? nt - 3 + (wave >> 1) : nt;
        for (int t = 0; t < nt; ++t) {
            if (t + 2 < nt) FA_GLOAD_K(t + 2);
            if (t + 1 < nt) FA_GLOAD_V(t + 1);
            if (t < ntw) {
            bf16x8 pa[2];
            FA_DECIDE(pmA)
            __builtin_amdgcn_sched_barrier(0);
            { FA_QK_HP(pB, kc, 512) FA_EXP_H(pA) FA_VPRE(t & 1, 0) FA_QKP_EXP_SGB }
            __builtin_amdgcn_sched_barrier(0);
            FA_MASK_H(pB, t, 1)
            __builtin_amdgcn_sched_barrier(0);
            { FA_PV_HP(t & 1, 0) FA_MAX_H(pB, pmB) FA_KPRE(kn, 0) FA_PVP_SGB }
            __builtin_amdgcn_sched_barrier(0);
            FA_DECIDE(pmB)
            __builtin_amdgcn_sched_barrier(0);
            if (t + 1 < ntw) { FA_QK_HP(pA, kn, 0) FA_EXP_H(pB) FA_VPRE(t & 1, 2) FA_QKP_EXP_SGB }
            else { FA_EXP_H(pB) FA_VPRE(t & 1, 2) }
            __builtin_amdgcn_sched_barrier(0);
            if (t + 1 < ntw) FA_MASK_H(pA, t + 1, 0)
            __builtin_amdgcn_sched_barrier(0);
            { FA_PV_HP(t & 1, 2) FA_MAX_H(pA, pmA) FA_KPRE(kn, 512) FA_PVP_SGB }
            __builtin_amdgcn_sched_barrier(0);
            }
            if (t + 2 < nt) FA_LWRITE_K(kw);
            if (t + 1 < nt) FA_LWRITE_V((t + 1) & 1);
            __syncthreads();
            { const int tmp_ = kc; kc = kn; kn = kw; kw = tmp_; }
        }
    }
#undef FA_GLOAD_K
#undef FA_GLOAD_V
#undef FA_LWRITE_K
#undef FA_LWRITE_V
#undef FA_QK_H
#undef FA_QK_SGB
#undef FA_KPRE
#undef FA_QK_HP
#undef FA_VPRE
#undef FA_PV_HP
#undef FA_QKP_EXP_SGB
#undef FA_PVP_SGB
#undef FA_QK_EXP_SGB
#undef FA_EXP_H
#undef FA_MASK_H
#undef FA_MAX_H
#undef FA_DECIDE
#undef FA_PV_H
    }
    constexpr int CPR = DV / 8, NGI = 32 * CPR / 64;
    u32x4 gpre[NGI];
    if (MODE != 4) {
#pragma unroll
        for (int i = 0; i < NGI; ++i) { const int q = lane + 64 * i, row = q / CPR, ch = q % CPR; gpre[i] = *(const u32x4*)(H + (tok0 + tokstep * row) * LDH + ycol + ch * 8); }
    }
    const float lt = sum_x32(l_reg);
    float fin = 1.0f / lt;
    const float lse = m_reg * SCALE + __logf(lt);
    if (MODE == 3) fin *= 1.0f / (1.0f + __expf(sinks[hh] - lse));
    if (hi == 0) li[c] = fin;
    asm volatile("s_waitcnt lgkmcnt(0)" ::: "memory");
    LAS bf16_t* stg = (LAS bf16_t*)(lds + OFF_STG + wave * 8192); LAS bf16_t* stgl = stg + 4 * hi * DV + c;
#pragma unroll
    for (int r = 0; r < 16; ++r) { const int cr = (r & 3) + 8 * (r >> 2); const float f = lih[cr];
#pragma unroll
        for (int d0 = 0; d0 < NDV; ++d0) stgl[cr * DV + 32 * d0] = (bf16_t)(cvt_pk_bf16(o[d0][r] * f, 0.f) & 0xffffu); }
    asm volatile("s_waitcnt lgkmcnt(0)" ::: "memory");
#pragma unroll
    for (int i = 0; i < NGI; ++i) {
        const int q = lane + 64 * i, row = q / CPR, ch = q % CPR;
        const u32x4 v = *(const LAS u32x4*)(stg + row * DV + ch * 8);
        const long tok = tok0 + tokstep * row;
        if (MODE == 4) { *(u32x4*)((bf16_t*)(ws + ws_op(pat)) + (size_t)tok * 768 + hh * 128 + ch * 8) = v; }
        else {
            bf16_t* yp = H + tok * LDH + ycol + ch * 8; const u32x4 g = gpre[i]; u32x4 w;
#define FA_GATE(vv, gg) cvt_pk_bf16(__uint_as_float((vv) << 16) * silu(__uint_as_float((gg) << 16)), __uint_as_float((vv) & 0xffff0000u) * silu(__uint_as_float((gg) & 0xffff0000u)))
            w.x = FA_GATE(v.x, g.x); w.y = FA_GATE(v.y, g.y); w.z = FA_GATE(v.z, g.z); w.w = FA_GATE(v.w, g.w);
#undef FA_GATE
            *(u32x4*)yp = w;
        }
    }
    if (MODE == 4 && hi == 0) ((float*)(ws + WS_LSE))[((size_t)pat * T + tok0 + tokstep * c) * 6 + hh] = lse;
}
}

#define XB_TMO      128
#define XB_XCNT(j)  (256  + 64 * (j))
#define XB_XSUB(j)  (1280 + 64 * (j))
#define XB_XGEN(j)  (2304 + 64 * (j))
#define XB_TOP      3328
#define XB_TOPGEN   3392
#define XCD_BAR_WORDS 3456
#define XB_SPIN_CAP (1u << 22)
__device__ __forceinline__ unsigned xb_ld(unsigned* p)              { return __hip_atomic_load(p, __ATOMIC_RELAXED, __HIP_MEMORY_SCOPE_AGENT); }
__device__ __forceinline__ unsigned xb_add(unsigned* p, unsigned v) { return __hip_atomic_fetch_add(p, v, __ATOMIC_RELAXED, __HIP_MEMORY_SCOPE_AGENT); }
__device__ __forceinline__ unsigned xb_xcc_id() { return (unsigned)__builtin_amdgcn_s_getreg((3 << 11) | 20) & 0xFu; }
#define XB_SPIN(cond, bar) do { unsigned _sp = 0; while (cond) { __builtin_amdgcn_s_sleep(1); \
    if ((++_sp & 255u) == 0u) { if (xb_ld(&(bar)[XB_TMO])) break; if (_sp > XB_SPIN_CAP) { atomicAdd(&(bar)[XB_TMO], 1u); break; } } } } while (0)
__device__ __forceinline__ void xcd_barrier_complete(unsigned* bar, unsigned x, unsigned& nloc, unsigned& nx) {
    const unsigned G = gridDim.x; unsigned sum, cnt, mine, sp = 0u;
    for (;;) {
        sum = 0u; cnt = 0u; mine = 0u;
#pragma unroll
        for (unsigned j = 0; j < 16; ++j) { const unsigned c = xb_ld(&bar[XB_XCNT(j)]); sum += c; cnt += (c > 0u) ? 1u : 0u; mine = (j == x) ? c : mine; }
        if (sum == G) break;
        __builtin_amdgcn_s_sleep(1);
        if ((++sp & 255u) == 0u) { if (xb_ld(&bar[XB_TMO])) break; if (sp > XB_SPIN_CAP) { atomicAdd(&bar[XB_TMO], 1u); break; } }
    }
    nloc = mine > 0u ? mine : 1u; nx = cnt > 0u ? cnt : 1u;
}
__device__ __forceinline__ void grid_barrier(unsigned* bar, volatile LAS unsigned* st, const int wave_s) {
    asm volatile("s_waitcnt vmcnt(0)" ::: "memory");
    __syncthreads();
    if (wave_s == 0 && lane_id() == 0) {
        const unsigned x = xb_xcc_id();
        __builtin_amdgcn_s_waitcnt(0);
        unsigned nloc = st[0], nx = st[1];
        if (nloc == 0u) { xcd_barrier_complete(bar, x, nloc, nx); st[0] = nloc; st[1] = nx; }
        const unsigned old = xb_add(&bar[XB_XSUB(x)], 1u);
        const unsigned gen = old / nloc;
        if (old + 1u == (gen + 1u) * nloc) {
            __builtin_amdgcn_fence(__ATOMIC_RELEASE, "agent");
            asm volatile("s_waitcnt vmcnt(0)" ::: "memory");
            const unsigned og = xb_add(&bar[XB_TOP], 1u);
            const unsigned tg = og / nx;
            if (og + 1u == (tg + 1u) * nx) {
#pragma unroll
                for (unsigned j = 0; j < 16; ++j) (void)xb_add(&bar[XB_XGEN(j)], 1u);
            } else XB_SPIN(xb_ld(&bar[XB_XGEN(x)]) == gen, bar);
            __builtin_amdgcn_fence(__ATOMIC_ACQUIRE, "agent");
            asm volatile("s_waitcnt vmcnt(0)" ::: "memory");
        } else {
            XB_SPIN(xb_ld(&bar[XB_XGEN(x)]) == gen, bar);
            __builtin_amdgcn_fence(__ATOMIC_ACQUIRE, "agent");
            asm volatile("s_waitcnt vmcnt(0)" ::: "memory");
        }
    }
    __syncthreads();
}

__device__ __forceinline__ int opaque_tid(int wave_s) { int t = wave_s * 64 + lane_id(); asm volatile("" : "+v"(t)); return t; }

constexpr int LDS_BYTES = 155648;
static_assert(fa::LDS_NEED <= LDS_BYTES - 64, "LDS map");
__global__ void __launch_bounds__(512, 2) mega(Args args) {
    extern __shared__ __attribute__((aligned(16))) unsigned char lds_raw[];
    LAS unsigned char* lds = (LAS unsigned char*)lds_raw;
    const int G = gridDim.x, NGW = G * 8;
    const int wave_s = __builtin_amdgcn_readfirstlane((int)threadIdx.x >> 6);
#define PHASE_IDS const int tid = opaque_tid(wave_s), lane = tid & 63, wave = wave_s, gw = blockIdx.x * 8 + wave; (void)lane; (void)gw;
#define KA() ({ auto p_ = __builtin_amdgcn_kernarg_segment_ptr(); asm volatile("" : "+s"(p_)); (const __attribute__((address_space(4))) Args*)p_; })
    unsigned char* ws = KA()->ws;
    const int lo = KA()->ph_lo, hi = KA()->ph_hi;
#define IN(k) (lo <= (k) && (k) < hi)
#define SEAM(k) do { if (IN(k) && IN((k) + 1)) { grid_barrier((unsigned*)(ws + WS_CTL) + 1024, (volatile LAS unsigned*)(lds + LDS_BYTES - 64), wave_s); } } while (0)
    if (lane_id() < 16 && wave_s == 0) ((LAS unsigned*)(lds + LDS_BYTES - 64))[lane_id()] = 0u;
    __syncthreads();
    if (hi - lo > 1 && wave_s == 0 && lane_id() == 0) (void)xb_add((unsigned*)(ws + WS_CTL) + 1024 + XB_XCNT(xb_xcc_id()), 1u);
    if (lo < 0) cg::this_grid().sync();
#define W1E ((bf16_t*)(ws + WS_W1E))
#define WUQ ((bf16_t*)(ws + WS_WUQ))
#define WUKV ((bf16_t*)(ws + WS_WUKV))
#define WMKE ((bf16_t*)(ws + WS_WMKE))
#define WOE ((bf16_t*)(ws + WS_WOE))
#define W1O ((bf16_t*)(ws + WS_W1O))
#define WMKO ((bf16_t*)(ws + WS_WMKO))
#define WOO ((bf16_t*)(ws + WS_WOO))
#define XB ((bf16_t*)(ws + WS_R1))
#define QA ((bf16_t*)KA()->out)
#define KVA ((bf16_t*)(ws + WS_KVA))
#define H ((bf16_t*)(ws + WS_H))
#define MEMB ((bf16_t*)(ws + WS_MEMB))
#define MKVE ((bf16_t*)(ws + WS_MKVE))
#define MKVO ((bf16_t*)(ws + WS_MKVO))
#define CS64 ((f32x2*)(ws + WS_CS64))
#define CS32 ((f32x2*)(ws + WS_CS32))
#define CS16 ((f32x2*)(ws + WS_CS16))
#define RS0 ((float*)(ws + WS_RS0))
#define SSQQ ((float*)(ws + WS_SSQQ))
#define SSQKV ((float*)(ws + WS_SSQKV))
#define SSQ1 ((float*)(ws + WS_SSQ1))
#define SSQ2 ((float*)(ws + WS_SSQ2))
#define RSMEM ((float*)(ws + WS_RSMEM))
#define KMEAN ((float*)(ws + WS_KMEAN))
    if (IN(0)) {
        PHASE_IDS
        LAS float* scr = (LAS float*)(lds + wave * 16640);
        constexpr int I0 = 32 * 112, I1 = 8 * 24, I2 = 4 * 32, I3 = 32 * 16, I6 = 32 * 16;
        constexpr int total = I0 + I1 + I2 + I3 + I6;
        for (int it = gw; it < total; it += NGW) {
            int r = it;
            if (r < I0) { transpose_item(KA()->in[3], 2048, 6976, W1E, KA()->in[2], 0, scr, r, 112, lane); continue; } r -= I0;
            if (r < I1) { transpose_item(KA()->in[5], 512, 1536, WUQ, KA()->in[4], 1, scr, r, 24, lane); continue; } r -= I1;
            if (r < I2) { transpose_item(KA()->in[7], 256, 2048, WUKV, KA()->in[6], 2, scr, r, 32, lane); continue; } r -= I2;
            if (r < I3) { transpose_item(KA()->in[9], 2048, 1024, WMKE, KA()->in[8], 3, scr, r, 16, lane); continue; } r -= I3;
            transpose_item(KA()->in[15], 2048, 1024, WMKO, KA()->in[14], 6, scr, r, 16, lane);
        }
        for (int m = gw - total % NGW + (gw < total % NGW ? NGW : 0); m < T + NB * NMEM; m += NGW) {
            if (m < T) row_to_bf16(KA()->in[0] + (size_t)m * DM, XB + (size_t)m * DM, RS0 + m, lane);
            else { const int mm = m - T; row_to_bf16(KA()->in[1] + (size_t)mm * DM, MEMB + (size_t)mm * DM, RSMEM + mm, lane); }
        }
        const int gt = blockIdx.x * 512 + tid, NGT = G * 512;
        for (int i = gt; i < SEQ * 56; i += NGT) {
            const int pos = i / 56, j = i - pos * 56; int rot, fi; f32x2* dst;
            if (j < 32) { rot = 64; fi = j; dst = CS64 + pos * 32 + fi; } else if (j < 48) { rot = 32; fi = j - 32; dst = CS32 + pos * 16 + fi; } else { rot = 16; fi = j - 48; dst = CS16 + pos * 8 + fi; }
            const float inv = 1.0f / powf(500000.0f, (float)(2 * fi) / (float)rot);
            const float ang = (float)pos * inv; float sn, cs; sincosf(ang, &sn, &cs);
            *dst = (f32x2){cs, sn};
        }
        for (int i = gt; i < T; i += NGT) { SSQQ[i] = 0.f; SSQKV[i] = 0.f; SSQ1[i] = 0.f; SSQ2[i] = 0.f; }
        if (gt < 64) ((unsigned*)(ws + WS_CTL))[gt] = 0u;
    }
    SEAM(0);
    if (IN(1)) {
        EpiBF<0> E{H, LDH0, RS0, nullptr, 0.f, SSQQ, SSQKV, CS64, CS32, CS16};
        run_gemm(lds, XB, DM, W1E, T, LDH0, DM, E, 0, wave_s);
    }
    SEAM(1);
    if (IN(2)) {
        PHASE_IDS
        for (int it0 = (int)blockIdx.x * 2; it0 < 512; it0 += G * 2) {
            const int it = it0 + (wave >> 2), q = wave & 3;
            const int b = it >> 7, n = (it >> 3) & 15, hh = it & 7;
            const bf16_t* kp = H + (size_t)(b * SEQ + n * 256 + q * 64) * LDH0 + E_KB + hh * 128 + 2 * lane; float s0 = 0.f, s1 = 0.f;
#pragma unroll 16
            for (int j = 0; j < 64; ++j) { const unsigned w = *(const unsigned*)(kp + (size_t)j * LDH0); s0 += __uint_as_float(w << 16); s1 += __uint_as_float(w & 0xffff0000u); }
            LAS float* part = (LAS float*)lds + wave * 128; part[2 * lane] = s0; part[2 * lane + 1] = s1;
            __syncthreads();
            if (q == 0) {
                const LAS float* p0 = (const LAS float*)lds + wave * 128 + 2 * lane;
                const float t0 = ((p0[0] + p0[128]) + p0[256]) + p0[384], t1 = ((p0[1] + p0[129]) + p0[257]) + p0[385];
                float* km = KMEAN + ((size_t)((b * 8 + hh) * 16 + n)) * 128 + 2 * lane; km[0] = t0 * (1.f / 256.f); km[1] = t1 * (1.f / 256.f);
            }
            __syncthreads();
        }
        { EpiBF<4> E{MKVE, 1024, RSMEM, nullptr, 0.f, nullptr, nullptr, CS64, CS32, CS16}; run_gemm(lds, MEMB, DM, WMKE, NB * NMEM, 1024, DM, E, 0, wave_s); }
        { EpiBF<4> E{MKVO, 1024, RSMEM, nullptr, 0.f, nullptr, nullptr, CS64, CS32, CS16}; run_gemm(lds, MEMB, DM, WMKO, NB * NMEM, 1024, DM, E, 240, wave_s); }
        { EpiBF<1> E{QA, 1536, nullptr, SSQQ, 1.f / 512.f, nullptr, nullptr, CS64, CS32, CS16}; pg8::StaticOrder S; S.init(T, 1536, G == 256 ? 224 : G, G == 256 ? (int)blockIdx.x - 32 : (int)blockIdx.x); run_gemm_s(lds, H + E_CQ, LDH0, WUQ, T, 1536, 512, E, S, wave_s); }
                { EpiBF<2> E{KVA, 2048, nullptr, SSQKV, 1.f / 256.f, nullptr, nullptr, CS64, CS32, CS16};
          pg8::StaticOrder S; int c2 = (int)blockIdx.x;
          if (G == 256) { c2 -= 32; if (c2 >= 0) c2 = c2 >= 160 ? c2 - 160 : c2 + 64; }
          S.init(T, 2048, G == 256 ? 224 : G, c2); run_gemm_s(lds, H + E_CKV, LDH0, WUKV, T, 2048, 256, E, S, wave_s); }
    }
    SEAM(2);
    if (IN(3)) {
        PHASE_IDS
        unsigned* ctr = (unsigned*)(ws + WS_CTL); volatile LAS unsigned* qw = (volatile LAS unsigned*)(lds + fa::OFF_Q);
        for (;;) {
            if (tid == 0) qw[0] = atomicAdd(ctr, 1u);
            __syncthreads();
            const int it = __builtin_amdgcn_readfirstlane((int)qw[0]);
            __syncthreads();
            if (it >= 1280 + 704) break;
            int ia = it, ic = -1;
            if (it >= 256) { const int j = it - 256, blk = j / 27, r = j - blk * 27, nc = (r * 11) / 27; if (((r + 1) * 11) / 27 > nc) ic = blk * 11 + nc; else ia = 256 + blk * 16 + (r - nc); }
            if (ic >= 0) {
                constexpr int I4 = 40 * 32, I5 = 32 * 100;
                LAS float* scr = (LAS float*)(lds + (wave < 6 ? wave * 16640 : 108800 + (wave - 6) * 16640));
                int r = ic * 8 + wave;
                int ln = lane_id(); asm volatile("" : "+v"(ln));
                if (r < I4) transpose_item(KA()->in[10], 2560, 2048, WOE, nullptr, 4, scr, r, 32, ln);
                else if (r < I4 + I5) transpose_item(KA()->in[12], 2048, 6400, W1O, KA()->in[11], 5, scr, r - I4, 100, ln);
                else transpose_item(KA()->in[16], 2304, 2048, WOO, nullptr, 7, scr, r - I4 - I5, 32, ln);
                continue;
            }
            if (ia < 1024) { const int item = (ia & ~63) / 2 + (ia & 31); if (((ia >> 5) & 1) == 0) fa::attn_item<0>(lds, ws, (const float*)KA()->out, item, wave_s); else fa::attn_item<1>(lds, ws, KA()->in[13], item, wave_s); }
            else fa::attn_item<2>(lds, ws, KA()->in[13], ia - 1024, wave_s);
        }
    }
    SEAM(3);
    if (IN(4)) {
        EpiRes<true, false> E{XB, nullptr, XB, DM, SSQ1};
        run_gemm(lds, H + E_G, LDH0, WOE, T, DM, 2560, E, 0, wave_s, WGM_OUT);
    }
    SEAM(4);
    if (IN(5)) {
        EpiBF<3> E{H, LDH1, nullptr, SSQ1, 1.f / DM, nullptr, nullptr, CS64, CS32, CS16};
        run_gemm(lds, XB, DM, W1O, T, 6144, DM, E, 0, wave_s);
    }
    SEAM(5);
    if (IN(6)) {
        PHASE_IDS
        if (blockIdx.x < 64) {
            EpiBF<3> E{H, LDH1, nullptr, SSQ1, 1.f / DM, nullptr, nullptr, CS64, CS32, CS16}; TailUnits S1{(int)blockIdx.x, G, 64, 24};
            run_gemm_s(lds, XB, DM, W1O, T, LDH1, DM, E, S1, wave_s);
            asm volatile("s_waitcnt vmcnt(0)" ::: "memory"); __syncthreads();
            if (tid == 0) { __builtin_amdgcn_fence(__ATOMIC_RELEASE, "agent"); asm volatile("s_waitcnt vmcnt(0)" ::: "memory"); __hip_atomic_fetch_add((unsigned*)(ws + WS_CTL) + 32, (unsigned)((64 - (int)blockIdx.x + G - 1) / G), __ATOMIC_RELAXED, __HIP_MEMORY_SCOPE_AGENT); }
        }
        unsigned* ctr = (unsigned*)(ws + WS_CTL) + 16; volatile LAS unsigned* qw = (volatile LAS unsigned*)(lds + fa::OFF_Q);
        unsigned nxt_ = 0u; if (tid == 0) nxt_ = atomicAdd(ctr, 1u);
        for (;;) {
            if (tid == 0) qw[0] = nxt_;
            __syncthreads();
            const int it = __builtin_amdgcn_readfirstlane((int)qw[0]);
            __syncthreads();
            if (it >= 1152 + 256 + 1024) break;
            if (tid == 0) nxt_ = atomicAdd(ctr, 1u);
            unsigned* tailcnt = (unsigned*)(ws + WS_CTL) + 32;
            const int it2 = it;
            if (it2 < 1152) fa::attn_item<4>(lds, ws, KA()->in[13], it2, wave_s);
            else if (it2 < 1408) {
                if (((it2 - 1152) >> 4) & 2) {
                    if (tid == 0) { unsigned sp = 0; while (__hip_atomic_load(tailcnt, __ATOMIC_RELAXED, __HIP_MEMORY_SCOPE_AGENT) < 64u && ++sp < (1u << 24)) __builtin_amdgcn_s_sleep(4);
                                    __builtin_amdgcn_fence(__ATOMIC_ACQUIRE, "agent"); asm volatile("s_waitcnt vmcnt(0)" ::: "memory"); }
                    __syncthreads();
                }
                fa::attn_item<5>(lds, ws, KA()->in[13], it2 - 1152, wave_s);
            }
            else fa::attn_item<3>(lds, ws, KA()->in[13], it2 - 1408, wave_s);
        }
    }
    SEAM(6);
    if (IN(7)) {
        PHASE_IDS
        const bf16_t* OP0 = (const bf16_t*)(ws + ws_op(0)); const bf16_t* OP1 = (const bf16_t*)(ws + ws_op(1)); const bf16_t* OP2 = (const bf16_t*)(ws + ws_op(2)); const float* LSE = (const float*)(ws + WS_LSE);
        for (int q = blockIdx.x * 512 + tid; q < T * 96; q += G * 512) {
            const int tok = q / 96, ch = q - tok * 96, hd = ch >> 4;
            const float l0 = LSE[(size_t)tok * 6 + hd], l1 = LSE[((size_t)T + tok) * 6 + hd], l2 = LSE[((size_t)2 * T + tok) * 6 + hd];
            const float mx = fmaxf(l0, fmaxf(l1, l2)); float w0 = __expf(l0 - mx), w1 = __expf(l1 - mx), w2 = __expf(l2 - mx); const float iw = 1.0f / (w0 + w1 + w2); w0 *= iw; w1 *= iw; w2 *= iw;
            const u32x4 a = *(const u32x4*)(OP0 + (size_t)tok * 768 + ch * 8), b = *(const u32x4*)(OP1 + (size_t)tok * 768 + ch * 8), c2 = *(const u32x4*)(OP2 + (size_t)tok * 768 + ch * 8);
            bf16_t* yp = H + (size_t)tok * LDH1 + O_G + 1024 + ch * 8; const u32x4 g = *(const u32x4*)yp; u32x4 w;
#define MIX(aa, bb, cc_, gg) cvt_pk_bf16((w0 * __uint_as_float((aa) << 16) + w1 * __uint_as_float((bb) << 16) + w2 * __uint_as_float((cc_) << 16)) * fa::silu(__uint_as_float((gg) << 16)), \
                (w0 * __uint_as_float((aa) & 0xffff0000u) + w1 * __uint_as_float((bb) & 0xffff0000u) + w2 * __uint_as_float((cc_) & 0xffff0000u)) * fa::silu(__uint_as_float((gg) & 0xffff0000u)))
            w.x = MIX(a.x, b.x, c2.x, g.x); w.y = MIX(a.y, b.y, c2.y, g.y); w.z = MIX(a.z, b.z, c2.z, g.z); w.w = MIX(a.w, b.w, c2.w, g.w);
#undef MIX
            *(u32x4*)yp = w;
        }
    }
    SEAM(7);
    if (IN(8)) {
        if (G == 256 && WGM_OUT == 4) { EpiFinal E{XB, KA()->out, DM, SSQ2, (unsigned*)(ws + WS_CTL) + 8192, KA()->in[17]}; run_gemm(lds, H + O_G, LDH1, WOO, T, DM, 2304, E, 0, wave_s, WGM_OUT); }
        else { EpiRes<true, false> E{XB, nullptr, XB, DM, SSQ2}; run_gemm(lds, H + O_G, LDH1, WOO, T, DM, 2304, E, 0, wave_s, WGM_OUT); }
    }
    if (!(G == 256 && WGM_OUT == 4)) SEAM(8);
    if (IN(9) && !(G == 256 && WGM_OUT == 4)) {
        PHASE_IDS
        const f32x4* gp = (const f32x4*)KA()->in[17] + 2 * lane;
        for (int m = gw; m < T; m += NGW) {
            const float r = 1.0f / sqrtf(SSQ2[m] * (1.0f / DM) + EPS);
            const u32x4* xr = (const u32x4*)(XB + (size_t)m * DM) + lane; f32x4* orow = (f32x4*)(KA()->out + (size_t)m * DM) + 2 * lane;
            u32x4 w[4];
#pragma unroll
            for (int j = 0; j < 4; ++j) w[j] = xr[64 * j];
#pragma unroll
            for (int j = 0; j < 4; ++j) { const f32x4 g0 = gp[128 * j], g1 = gp[128 * j + 1];
                f32x4 v0 = {__uint_as_float(w[j].x << 16), __uint_as_float(w[j].x & 0xffff0000u), __uint_as_float(w[j].y << 16), __uint_as_float(w[j].y & 0xffff0000u)};
                f32x4 v1 = {__uint_as_float(w[j].z << 16), __uint_as_float(w[j].z & 0xffff0000u), __uint_as_float(w[j].w << 16), __uint_as_float(w[j].w & 0xffff0000u)};
                v0 = v0 * r; v0 = v0 * g0; v1 = v1 * r; v1 = v1 * g1; orow[128 * j] = v0; orow[128 * j + 1] = v1; }
        }
    }
#undef KA
#undef PHASE_IDS
#undef IN
#undef SEAM
#undef W1E
#undef WUQ
#undef WUKV
#undef WMKE
#undef WOE
#undef W1O
#undef WMKO
#undef WOO
#undef XB
#undef QA
#undef KVA
#undef H
#undef MEMB
#undef MKVE
#undef MKVO
#undef CS64
#undef CS32
#undef CS16
#undef RS0
#undef SSQQ
#undef SSQKV
#undef SSQ1
#undef SSQ2
#undef RSMEM
#undef KMEAN
}

extern "C" void kernel_launch(void* const* d_in, const int* in_sizes, int n_in, void* d_out, int out_size, void* d_ws, size_t ws_size, hipStream_t stream) {
    static int grid = 0;
    if (grid == 0) {
        if (n_in != 18 || out_size != T * DM || ws_size < WS_END) { fprintf(stderr, "kernel_launch: unexpected shapes (n_in %d out %d ws %zu)\n", n_in, out_size, ws_size); grid = -1; return; }
        int dev = 0, cus = 0, per_cu = 0;
        (void)hipGetDevice(&dev); (void)hipDeviceGetAttribute(&cus, hipDeviceAttributeMultiprocessorCount, dev);
        if (hipFuncSetAttribute((const void*)mega, hipFuncAttributeMaxDynamicSharedMemorySize, LDS_BYTES) != hipSuccess) { fprintf(stderr, "kernel_launch: hipFuncSetAttribute failed\n"); grid = -1; return; }
        (void)hipOccupancyMaxActiveBlocksPerMultiprocessor(&per_cu, (const void*)mega, 512, LDS_BYTES);
        if (per_cu < 1) { fprintf(stderr, "kernel_launch: occupancy query says %d\n", per_cu); per_cu = 1; }
        grid = (cus > 0 ? cus : 256) * 1;
        (void)hipGetLastError();
    }
    if (grid < 0) return;
    (void)hipMemsetAsync((unsigned char*)d_ws + WS_CTL, 0, 65536, stream);
    Args a{};
    for (int i = 0; i < 18; ++i) a.in[i] = (const float*)d_in[i];
    a.out = (float*)d_out; a.ws = (unsigned char*)d_ws;
    a.ph_lo = 0; a.ph_hi = 10;
    void* kargs[] = {&a};
    hipError_t e = hipLaunchCooperativeKernel((const void*)mega, dim3(grid), dim3(512), kargs, LDS_BYTES, stream);
    if (e != hipSuccess) fprintf(stderr, "kernel_launch: cooperative launch failed: %s (grid %d)\n", hipGetErrorString(e), grid);

}
```

```cpp
#include <hip/hip_runtime.h>
#include <hip/hip_cooperative_groups.h>
#include <cstdio>
#include <cstdint>
namespace cg = cooperative_groups;

#ifndef WGM_OUT
#define WGM_OUT 4
#endif
typedef unsigned short bf16_t;
typedef short bf16x8 __attribute__((ext_vector_type(8)));
typedef float f32x4 __attribute__((ext_vector_type(4)));
typedef float f32x2 __attribute__((ext_vector_type(2)));
typedef unsigned u32x4 __attribute__((ext_vector_type(4)));
typedef unsigned u32x2 __attribute__((ext_vector_type(2)));
#define LAS __attribute__((address_space(3)))

constexpr int NB = 4, SEQ = 4096, DM = 2048, T = NB * SEQ, NMEM = 256;
constexpr int LDH0 = 7168, LDH1 = 6400;
constexpr float EPS = 1e-6f;
constexpr int E_CQ = 0, E_CKV = 512, E_KPE = 768, E_QB = 1024, E_KB = 2048, E_VB = 3072, E_QM = 4096, E_G = 4608;
constexpr int O_QC = 0, O_KC = 1024, O_VC = 1152, O_QD = 1280, O_KD = 2048, O_VD = 2816, O_QM = 3584, O_G = 4096;

constexpr size_t MiB = 1u << 20;
constexpr size_t WS_W1E = 0, WS_WUQ = 28 * MiB, WS_WUKV = 30 * MiB, WS_WMKE = 31 * MiB, WS_WOE = 35 * MiB, WS_W1O = 45 * MiB,
                 WS_WMKO = 70 * MiB, WS_WOO = 74 * MiB;
constexpr size_t WS_R1 = 96 * MiB;
constexpr size_t WS_KVA = WS_R1 + 64 * MiB;
constexpr size_t WS_H = 224 * MiB;
constexpr size_t WS_MISC = 448 * MiB;
constexpr size_t WS_MEMB = WS_MISC, WS_MKVE = WS_MISC + 4 * MiB, WS_MKVO = WS_MISC + 6 * MiB;
constexpr size_t WS_CS64 = WS_MISC + 8 * MiB, WS_CS32 = WS_MISC + 9 * MiB, WS_CS16 = WS_MISC + 9 * MiB + 512 * 1024;
constexpr size_t WS_RS0 = WS_MISC + 10 * MiB, WS_SSQQ = WS_RS0 + 65536, WS_SSQKV = WS_RS0 + 2 * 65536, WS_SSQ1 = WS_RS0 + 3 * 65536,
                 WS_SSQ2 = WS_RS0 + 4 * 65536, WS_RSMEM = WS_RS0 + 5 * 65536;
constexpr size_t WS_KMEAN = WS_MISC + 11 * MiB;
constexpr size_t WS_LSE = WS_MISC + 12 * MiB;
constexpr size_t WS_CTL = WS_MISC + 14 * MiB;
constexpr size_t WS_KD = 424 * MiB, WS_VD = 464 * MiB;
constexpr size_t WS_KC = 488 * MiB, WS_VC = 492 * MiB;
constexpr size_t WS_END = 496 * MiB;
__host__ __device__ constexpr size_t ws_op(int p) { return p == 0 ? (size_t)0 : WS_R1 + (size_t)(64 + 24 * (p - 1)) * MiB; }

struct Args { const float* in[18]; float* out; unsigned char* ws; int ph_lo, ph_hi; };

__device__ __forceinline__ int lane_id() { int r = (int)__builtin_amdgcn_mbcnt_hi(~0u, __builtin_amdgcn_mbcnt_lo(~0u, 0u)); asm volatile("" : "+v"(r)); return r; }
template <int MASK> __device__ __forceinline__ float swz_xor(float v) { return __uint_as_float((unsigned)__builtin_amdgcn_ds_swizzle((int)__float_as_uint(v), (MASK << 10) | 0x1F)); }
__device__ __forceinline__ float sum_x32(float v) { auto rr = __builtin_amdgcn_permlane32_swap(__float_as_uint(v), __float_as_uint(v), false, false); return __uint_as_float(rr[0]) + __uint_as_float(rr[1]); }
__device__ __forceinline__ float max_x32(float v) { auto rr = __builtin_amdgcn_permlane32_swap(__float_as_uint(v), __float_as_uint(v), false, false); return fmaxf(__uint_as_float(rr[0]), __uint_as_float(rr[1])); }
__device__ __forceinline__ float xchg_x32(float v) { auto rr = __builtin_amdgcn_permlane32_swap(__float_as_uint(v), __float_as_uint(v), false, false); return __uint_as_float(rr[0] ^ rr[1] ^ __float_as_uint(v)); }
__device__ __forceinline__ float bf2f(bf16_t b) { return __uint_as_float((unsigned)b << 16); }
typedef __bf16 bf16x2_t __attribute__((ext_vector_type(2)));
__device__ __forceinline__ unsigned cvt_pk_bf16(float lo, float hi) { const f32x2 v = {lo, hi}; return __builtin_bit_cast(unsigned, __builtin_convertvector(v, bf16x2_t)); }
__device__ __forceinline__ float wave_sum(float v) {
    v += swz_xor<1>(v); v += swz_xor<2>(v); v += swz_xor<4>(v); v += swz_xor<8>(v); v += swz_xor<16>(v); return sum_x32(v);
}
__device__ __forceinline__ float wave_max(float v) {
    v = fmaxf(v, swz_xor<1>(v)); v = fmaxf(v, swz_xor<2>(v)); v = fmaxf(v, swz_xor<4>(v)); v = fmaxf(v, swz_xor<8>(v)); v = fmaxf(v, swz_xor<16>(v)); return max_x32(v);
}

__device__ __forceinline__ void blockmap(int mat, int db, int& src, int& half) {
    src = 64 * db; half = 0;
    if (mat == 0) {
        if (db < 12) return;
        if (db == 12) { half = 32; return; }
        if (db < 16) { src = -1; return; }
        if (db < 64) { const int j = 64 * db - 1024; src = 832 + j; if ((j >> 10) < 2 && (j & 127) == 0) half = 16; return; }
        if (db < 72) { src = 3904 + (64 * db - 4096); return; }
        src = 4416 + (64 * db - 4608); return;
    }
    if (mat == 1) { if (db % 3 == 2) half = 32; return; }
    if (mat == 5) { if (db < 18) half = 8; else if (db >= 20 && db < 56) { const int j = 64 * db - 1280; if (j / 768 < 2 && (j & 127) == 0) half = 16; } return; }
}
__device__ __forceinline__ void transpose_item(const float* W, int K, int Nsrc, bf16_t* WT, const float* g, int mat, LAS float* scr, int item, int nblk, int lane) {
    const int kb = item / nblk, db = item - kb * nblk, k0 = 64 * kb, n0 = 64 * db;
    int src, half; blockmap(mat, db, src, half);
    const int s4 = 4 * (lane & 15), kr = lane >> 4;
    f32x4 v[16];
    if (src >= 0) {
#pragma unroll
        for (int i = 0; i < 16; ++i) v[i] = __builtin_nontemporal_load((const f32x4*)(W + (size_t)(k0 + kr + 4 * i) * Nsrc + src + s4));
        if (g) {
#pragma unroll
            for (int i = 0; i < 16; ++i) v[i] = v[i] * g[k0 + kr + 4 * i];
        }
    } else {
#pragma unroll
        for (int i = 0; i < 16; ++i) v[i] = (f32x4){0.f, 0.f, 0.f, 0.f};
    }
    int dr[4];
#pragma unroll
    for (int e = 0; e < 4; ++e) { const int sc_ = s4 + e; dr[e] = sc_ < 2 * half ? (sc_ < half ? 2 * sc_ : 2 * (sc_ - half) + 1) : sc_; }
#pragma unroll
    for (int i = 0; i < 16; ++i) { LAS float* rowp = scr + (kr + 4 * i) * 65; rowp[dr[0]] = v[i].x; rowp[dr[1]] = v[i].y; rowp[dr[2]] = v[i].z; rowp[dr[3]] = v[i].w; }
    asm volatile("s_waitcnt lgkmcnt(0)" ::: "memory");
    const int c = lane & 7;
#pragma unroll
    for (int j = 0; j < 8; ++j) { const int n = (lane >> 3) + 8 * j; const LAS float* sp = scr + (8 * c) * 65 + n;
        u32x4 o; o.x = cvt_pk_bf16(sp[0 * 65], sp[1 * 65]); o.y = cvt_pk_bf16(sp[2 * 65], sp[3 * 65]); o.z = cvt_pk_bf16(sp[4 * 65], sp[5 * 65]); o.w = cvt_pk_bf16(sp[6 * 65], sp[7 * 65]);
        *(u32x4*)(WT + (size_t)(n0 + n) * K + k0 + 8 * c) = o; }
    asm volatile("s_waitcnt lgkmcnt(0)" ::: "memory");
}

__device__ __forceinline__ void row_to_bf16(const float* xrow, bf16_t* orow, float* rs, int lane) {
    const f32x4* xr = (const f32x4*)xrow + lane; f32x4 v[8]; float s = 0.f;
#pragma unroll
    for (int j = 0; j < 8; ++j) { v[j] = __builtin_nontemporal_load(xr + 64 * j); s += (v[j].x * v[j].x + v[j].y * v[j].y) + (v[j].z * v[j].z + v[j].w * v[j].w); }
    s = wave_sum(s);
    if (lane == 0) *rs = 1.0f / sqrtf(s * (1.0f / DM) + EPS);
    u32x2* o8 = (u32x2*)orow + lane;
#pragma unroll
    for (int j = 0; j < 8; ++j) { u32x2 w; w.x = cvt_pk_bf16(v[j].x, v[j].y); w.y = cvt_pk_bf16(v[j].z, v[j].w); o8[64 * j] = w; }
}

namespace pg8 {
constexpr int BM = 256, BK = 64, HALF = 128, HTB = HALF * BK * 2, STAGE_BYTES = 8 * HTB, NXCD = 8;
__host__ __device__ __forceinline__ int lds_byte(int r, int c) { const int st = (r >> 4) * 2 + (c >> 5), rr = r & 15, cc = c & 31, ob = rr * 64 + cc * 2; return st * 1024 + (ob ^ (((ob >> 9) & 1) << 5)); }
__host__ __device__ __forceinline__ void stage_rc(int b, int& R, int& C) { const int st = b / 1024, sb = b % 1024, swz = sb ^ (((sb >> 9) & 1) << 5); R = (st >> 1) * 16 + swz / 64; C = (st & 1) * 32 + (swz % 64) / 2; }
__host__ __device__ __forceinline__ int perm32(int rho) { const int n = rho >> 4, i = rho & 15; return 8 * (i >> 2) + 4 * n + (i & 3); }
struct Unit { int pm, pn; };
struct Gemm { const bf16_t* A; const bf16_t* Bt; int M, N, K, lda; };
struct StaticOrder {
    int nM, nN, nwg, G, c, WGM;
    __host__ __device__ void init(int M, int N, int G_, int c_, int wgm_ = 2) { nM = M / BM; nN = N / BM; nwg = nM * nN; G = G_; c = c_; WGM = wgm_; }
    __host__ __device__ void unit_of(int L, Unit& u) const {
        int wgid = L; { const int q = nwg / NXCD, r = nwg % NXCD, xcd = wgid % NXCD, off = wgid / NXCD; wgid = (xcd < r ? xcd * (q + 1) : r * (q + 1) + (xcd - r) * q) + off; }
        const int nig = WGM * nN, gid = wgid / nig, fm = gid * WGM, gsz = (nM - fm) < WGM ? (nM - fm) : WGM;
        u.pm = fm + ((wgid % nig) % gsz); u.pn = (wgid % nig) / gsz;
    }
    __host__ __device__ bool next(int i, Unit& u) const {
        if (c < 0) return false;
        const long L = (long)i * G + c; if (L >= nwg) return false;
        unit_of((int)L, u); return true;
    }
};

template <class Epi, class Sched>
__device__ __forceinline__ void gemm_phase(LAS unsigned char* lds, const Gemm g, const Sched& S, const Epi& E, const int wid) {
    const int lane = lane_id(), tid = wid * 64 + lane, wr = wid >> 2, wc = wid & 3, fr = lane & 15, fq = lane >> 4;
    const int K = g.K, nt = K / BK;
    unsigned voffA[2], voffB[2];
#pragma unroll
    for (int i = 0; i < 2; ++i) { int R, C; stage_rc(tid * 16 + i * 8192, R, C); const int Rb = (R & ~31) + perm32(R & 31); voffA[i] = (unsigned)(R * g.lda + C) * 2u; voffB[i] = (unsigned)(Rb * K + C) * 2u; }
    const size_t kstep = (size_t)(BK * 2);
    const size_t hstepA = (size_t)HALF * g.lda * 2, hstepB = (size_t)HALF * K * 2, tstepA = 2 * hstepA, tstepB = 2 * hstepB;
    const unsigned ldsw = (unsigned)wid * 1024u;
    const int aoff = lds_byte(wr * 64 + fr, fq * 8), boff = lds_byte(wc * 32 + fr, fq * 8);
#define PG8_SA(b, h) (((b) * 2 + (h)) * HTB)
#define PG8_SB(b, h) ((4 + (b) * 2 + (h)) * HTB)
#define PG8_STAGE(bufoff, gbase, voff) do { _Pragma("unroll") for (int _i = 0; _i < 2; ++_i) \
        __builtin_amdgcn_global_load_lds((const unsigned*)((const char*)(gbase) + (voff)[_i]), (LAS unsigned*)(lds + (bufoff) + ldsw + _i * 8192), 16, 0, 0); } while (0)
#define PG8_LDA(dst, b, h) do { _Pragma("unroll") for (int m = 0; m < 4; ++m) _Pragma("unroll") for (int k = 0; k < 2; ++k) dst[m][k] = *(const LAS bf16x8*)(lds + PG8_SA(b, h) + aoff + m * 2048 + k * 1024); } while (0)
#define PG8_LDB(dst, b, h) do { _Pragma("unroll") for (int n = 0; n < 2; ++n) _Pragma("unroll") for (int k = 0; k < 2; ++k) dst[n][k] = *(const LAS bf16x8*)(lds + PG8_SB(b, h) + boff + n * 2048 + k * 1024); } while (0)
#define PG8_MMA(ai, bj, At, Bt) do { __builtin_amdgcn_s_setprio(1); _Pragma("unroll") for (int m = 0; m < 4; ++m) _Pragma("unroll") for (int n = 0; n < 2; ++n) _Pragma("unroll") for (int k = 0; k < 2; ++k) \
        acc[ai][bj][m][n] = __builtin_amdgcn_mfma_f32_16x16x32_bf16(Bt[n][k], At[m][k], acc[ai][bj][m][n], 0, 0, 0); __builtin_amdgcn_s_setprio(0); } while (0)
#define PG8_WAIT_V(n) asm volatile("s_waitcnt vmcnt(" #n ")" ::: "memory")
#define PG8_WAIT_L(n) asm volatile("s_waitcnt lgkmcnt(" #n ")" ::: "memory")
#define PG8_BAR __builtin_amdgcn_s_barrier()
#define PG8_SCHED __builtin_amdgcn_sched_barrier(0)
    Unit cur, nxt; int ui = 0;
    if (!S.next(0, cur)) return;
    f32x4 acc[2][2][4][2];
#pragma unroll
    for (int a = 0; a < 2; ++a)
#pragma unroll
        for (int b = 0; b < 2; ++b)
#pragma unroll
            for (int m = 0; m < 4; ++m)
#pragma unroll
                for (int n = 0; n < 2; ++n) acc[a][b][m][n] = (f32x4){0.f, 0.f, 0.f, 0.f};
    bf16x8 At[4][2], B0[2][2], B1[2][2];
    const char* cA = (const char*)g.A + (size_t)cur.pm * tstepA; const char* cB = (const char*)g.Bt + (size_t)cur.pn * tstepB;
    PG8_STAGE(PG8_SB(0, 0), cB, voffB); PG8_STAGE(PG8_SB(0, 1), cB + hstepB, voffB); PG8_STAGE(PG8_SA(0, 0), cA, voffA); PG8_STAGE(PG8_SA(0, 1), cA + hstepA, voffA);
    if (wr == 1) PG8_BAR;
    PG8_WAIT_V(2); PG8_BAR;
    PG8_STAGE(PG8_SB(1, 0), cB + kstep, voffB); PG8_STAGE(PG8_SA(1, 0), cA + kstep, voffA); PG8_STAGE(PG8_SB(1, 1), cB + hstepB + kstep, voffB);
    PG8_WAIT_V(6); PG8_BAR;
    for (;;) {
        const bool has_next = S.next(ui + 1, nxt);
        const char* nA = has_next ? (const char*)g.A + (size_t)nxt.pm * tstepA : cA; const char* nB = has_next ? (const char*)g.Bt + (size_t)nxt.pn * tstepB : cB;
#pragma unroll 1
        for (int t = 0; t < nt; t += 2) {
            const bool last = (t == nt - 2);
            const char* a1 = cA + (size_t)(t + 1) * kstep;
            const char* a2 = last ? nA : cA + (size_t)(t + 2) * kstep; const char* b2 = last ? nB : cB + (size_t)(t + 2) * kstep;
            const char* a3 = a2 + kstep; const char* b3 = b2 + kstep;
            PG8_LDB(B0, 0, 0); PG8_LDB(B1, 0, 1); PG8_SCHED; PG8_LDA(At, 0, 0); PG8_STAGE(PG8_SA(1, 1), a1 + hstepA, voffA);
            PG8_WAIT_V(8); PG8_WAIT_L(0); PG8_BAR; PG8_MMA(0, 0, At, B0); PG8_MMA(0, 1, At, B1); PG8_BAR; PG8_SCHED;
            PG8_LDA(At, 0, 1); PG8_STAGE(PG8_SB(0, 0), b2, voffB); PG8_STAGE(PG8_SB(0, 1), b2 + hstepB, voffB); PG8_STAGE(PG8_SA(0, 0), a2, voffA);
            PG8_WAIT_V(8); PG8_WAIT_L(0); PG8_BAR; PG8_MMA(1, 0, At, B0); PG8_MMA(1, 1, At, B1); PG8_BAR; PG8_SCHED;
            PG8_LDB(B0, 1, 0); PG8_LDB(B1, 1, 1); PG8_SCHED; PG8_LDA(At, 1, 0); PG8_STAGE(PG8_SA(0, 1), a2 + hstepA, voffA);
            PG8_WAIT_V(8); PG8_WAIT_L(0); PG8_BAR; PG8_MMA(0, 0, At, B0); PG8_MMA(0, 1, At, B1); PG8_BAR; PG8_SCHED;
            PG8_LDA(At, 1, 1); PG8_STAGE(PG8_SB(1, 0), b3, voffB); PG8_STAGE(PG8_SB(1, 1), b3 + hstepB, voffB); PG8_STAGE(PG8_SA(1, 0), a3, voffA);
            PG8_WAIT_V(8); PG8_WAIT_L(0); PG8_BAR; PG8_MMA(1, 0, At, B0); PG8_MMA(1, 1, At, B1); PG8_BAR; PG8_SCHED;
        }
        if (wr == 0) PG8_BAR;
        E(acc, cur, wr, wc, fr, fq);
        if (!has_next) break;
#pragma unroll
        for (int a = 0; a < 2; ++a)
#pragma unroll
            for (int b = 0; b < 2; ++b)
#pragma unroll
                for (int m = 0; m < 4; ++m)
#pragma unroll
                    for (int n = 0; n < 2; ++n) acc[a][b][m][n] = (f32x4){0.f, 0.f, 0.f, 0.f};
        cur = nxt; cA = nA; cB = nB; ++ui;
        if (wr == 1) PG8_BAR;
    }
    PG8_WAIT_V(0);
    PG8_BAR;
#undef PG8_SA
#undef PG8_SB
#undef PG8_STAGE
#undef PG8_LDA
#undef PG8_LDB
#undef PG8_MMA
#undef PG8_WAIT_V
#undef PG8_WAIT_L
#undef PG8_BAR
#undef PG8_SCHED
}
}

template <int MODE> struct EpiBF {
    bf16_t* O; int ldc; const float* rs; const float* ssq_in; float inv_n; float* ssq_a; float* ssq_b;
    const f32x2* cs64; const f32x2* cs32; const f32x2* cs16;
    __device__ __forceinline__ void operator()(const f32x4 (&acc)[2][2][4][2], const pg8::Unit& u, int wr, int wc, int fr, int fq) const {
        asm volatile("" : "+v"(fr), "+v"(fq));
        const int row0 = u.pm * 256 + wr * 64 + fr;
        float sc[2][4];
#pragma unroll
        for (int ai = 0; ai < 2; ++ai)
#pragma unroll
            for (int m = 0; m < 4; ++m) sc[ai][m] = (MODE == 1 || MODE == 2 || MODE == 3) ? ssq_in[row0 + ai * 128 + m * 16] : rs[row0 + ai * 128 + m * 16];
        if (MODE == 1 || MODE == 2 || MODE == 3) {
#pragma unroll
            for (int ai = 0; ai < 2; ++ai)
#pragma unroll
                for (int m = 0; m < 4; ++m) sc[ai][m] = 1.0f / sqrtf(sc[ai][m] * inv_n + EPS);
        }
        float ss[2][4] = {{0.f, 0.f, 0.f, 0.f}, {0.f, 0.f, 0.f, 0.f}};
        const bool do_ss = (MODE == 0) && u.pn < 3 && ssq_a != nullptr;
#pragma unroll
        for (int bj = 0; bj < 2; ++bj) {
            const int colb = u.pn * 256 + bj * 128 + wc * 32, col = colb + 8 * fq;
            bf16_t* dst = O; int dld = ldc, dcol = col;
            if (MODE == 3) {
                unsigned char* wsb = (unsigned char*)O - WS_H;
                if (u.pn == 4) { dst = (bf16_t*)(wsb + (bj == 0 ? WS_KC : WS_VC)) + (size_t)(wc >> 1) * T * 64; dld = 64; dcol = (wc & 1) * 32 + 8 * fq; }
                else if (u.pn >= 8 && u.pn < 14) { const int hd = u.pn * 2 + bj - (u.pn < 11 ? 16 : 22); dst = (bf16_t*)(wsb + (u.pn < 11 ? WS_KD : WS_VD)) + (size_t)hd * T * 128; dld = 128; dcol = wc * 32 + 8 * fq; }
            }
            const f32x2* tb = nullptr; int nf = 0, i0 = 4 * fq; bool lrope = true;
            if (MODE == 0) {
                if (u.pn == 3 && bj == 0 && wc < 2) { tb = cs64; nf = 32; i0 = wc * 16 + 4 * fq; }
                else if (u.pn >= 4 && u.pn < 12 && wc == 0) { tb = cs32; nf = 16; }
            } else if (MODE == 1) {
                const int d = colb % 192; if (d >= 128) { tb = cs64; nf = 32; i0 = ((d - 128) >> 1) + 4 * fq; }
            } else if (MODE == 3) {
                if ((u.pn < 4 || (u.pn == 4 && bj == 0)) && (wc & 1) == 0) { tb = cs16; nf = 8; lrope = fq < 2; if (!lrope) i0 = 0; }
                else if (u.pn >= 5 && u.pn < 11 && wc == 0) { tb = cs32; nf = 16; }
            }
            if (tb != nullptr) {
#pragma unroll
                for (int h4 = 0; h4 < 4; ++h4) {
                    const int ai = h4 >> 1, mb = (h4 & 1) * 2;
                    f32x4 t0[2], t1[2];
#pragma unroll
                    for (int mm = 0; mm < 2; ++mm) { const int pos = (row0 + ai * 128 + (mb + mm) * 16) & (SEQ - 1); const f32x4* tp = (const f32x4*)(tb + pos * nf + i0); t0[mm] = tp[0]; t1[mm] = tp[1]; }
#pragma unroll
                    for (int mm = 0; mm < 2; ++mm) { const int m = mb + mm;
                        const f32x4 v0 = acc[ai][bj][m][0] * sc[ai][m], v1 = acc[ai][bj][m][1] * sc[ai][m]; const f32x4 a = t0[mm], b = t1[mm];
                        f32x4 r0, r1;
                        r0.x = v0.x * a.x - v0.y * a.y; r0.y = v0.x * a.y + v0.y * a.x; r0.z = v0.z * a.z - v0.w * a.w; r0.w = v0.z * a.w + v0.w * a.z;
                        r1.x = v1.x * b.x - v1.y * b.y; r1.y = v1.x * b.y + v1.y * b.x; r1.z = v1.z * b.z - v1.w * b.w; r1.w = v1.z * b.w + v1.w * b.z;
                        if (!lrope) { r0 = v0; r1 = v1; }
                        u32x4 w; w.x = cvt_pk_bf16(r0.x, r0.y); w.y = cvt_pk_bf16(r0.z, r0.w); w.z = cvt_pk_bf16(r1.x, r1.y); w.w = cvt_pk_bf16(r1.z, r1.w);
                        *(u32x4*)(dst + (size_t)(row0 + ai * 128 + m * 16) * dld + dcol) = w;
                    }
                }
            } else {
#pragma unroll
                for (int ai = 0; ai < 2; ++ai)
#pragma unroll
                    for (int m = 0; m < 4; ++m) {
                        const f32x4 v0 = acc[ai][bj][m][0] * sc[ai][m], v1 = acc[ai][bj][m][1] * sc[ai][m];
                        if (MODE == 0) ss[ai][m] += ((v0.x * v0.x + v0.y * v0.y) + (v0.z * v0.z + v0.w * v0.w)) + ((v1.x * v1.x + v1.y * v1.y) + (v1.z * v1.z + v1.w * v1.w));
                        u32x4 w; w.x = cvt_pk_bf16(v0.x, v0.y); w.y = cvt_pk_bf16(v0.z, v0.w); w.z = cvt_pk_bf16(v1.x, v1.y); w.w = cvt_pk_bf16(v1.z, v1.w);
                        *(u32x4*)(dst + (size_t)(row0 + ai * 128 + m * 16) * dld + dcol) = w;
                    }
            }
        }
        if (do_ss) {
            float* dst = u.pn < 2 ? ssq_a : ssq_b;
#pragma unroll
            for (int ai = 0; ai < 2; ++ai)
#pragma unroll
                for (int m = 0; m < 4; ++m) { float t = ss[ai][m]; t += swz_xor<16>(t); t = sum_x32(t); if (fq == 0) atomicAdd(dst + row0 + ai * 128 + m * 16, t); }
        }
    }
};
template <bool BB, bool WF> struct EpiRes {
    const void* base; float* out; bf16_t* ob; int ldc; float* ssq;
    __device__ __forceinline__ void operator()(const f32x4 (&acc)[2][2][4][2], const pg8::Unit& u, int wr, int wc, int fr, int fq) const {
        asm volatile("" : "+v"(fr), "+v"(fq));
        const int row0 = u.pm * 256 + wr * 64 + fr, col0 = u.pn * 256 + wc * 32 + 8 * fq;
#pragma unroll
        for (int h2 = 0; h2 < 4; ++h2) {
            const int ai = h2 >> 1, mb = (h2 & 1) * 2;
            f32x4 pre[2][2][2];
#pragma unroll
            for (int mm = 0; mm < 2; ++mm)
#pragma unroll
                for (int bj = 0; bj < 2; ++bj) {
                    const size_t off = (size_t)(row0 + ai * 128 + (mb + mm) * 16) * ldc + col0 + bj * 128;
                    if (BB) { const u32x4 w = *(const u32x4*)((const bf16_t*)base + off);
                        pre[mm][bj][0] = (f32x4){__uint_as_float(w.x << 16), __uint_as_float(w.x & 0xffff0000u), __uint_as_float(w.y << 16), __uint_as_float(w.y & 0xffff0000u)};
                        pre[mm][bj][1] = (f32x4){__uint_as_float(w.z << 16), __uint_as_float(w.z & 0xffff0000u), __uint_as_float(w.w << 16), __uint_as_float(w.w & 0xffff0000u)}; }
                    else { const float* p = (const float*)base + off; pre[mm][bj][0] = *(const f32x4*)p; pre[mm][bj][1] = *(const f32x4*)(p + 4); } }
#pragma unroll
            for (int mm = 0; mm < 2; ++mm) {
                const int m = mb + mm, row = row0 + ai * 128 + m * 16; float ss = 0.f;
#pragma unroll
                for (int bj = 0; bj < 2; ++bj) {
                    const size_t off = (size_t)row * ldc + col0 + bj * 128;
                    const f32x4 o0 = pre[mm][bj][0] + acc[ai][bj][m][0], o1 = pre[mm][bj][1] + acc[ai][bj][m][1];
                    if (WF) { *(f32x4*)(out + off) = o0; *(f32x4*)(out + off + 4) = o1; }
                    ss += ((o0.x * o0.x + o0.y * o0.y) + (o0.z * o0.z + o0.w * o0.w)) + ((o1.x * o1.x + o1.y * o1.y) + (o1.z * o1.z + o1.w * o1.w));
                    if (ob) { u32x4 w; w.x = cvt_pk_bf16(o0.x, o0.y); w.y = cvt_pk_bf16(o0.z, o0.w); w.z = cvt_pk_bf16(o1.x, o1.y); w.w = cvt_pk_bf16(o1.z, o1.w); *(u32x4*)(ob + off) = w; }
                }
                if (ssq) { ss += swz_xor<16>(ss); ss = sum_x32(ss); if (fq == 0) atomicAdd(ssq + row, ss); }
            }
        }
    }
};

struct EpiFinal {
    const bf16_t* base; float* out; int ldc; float* ssq; unsigned* cnt; const float* g;
    __device__ __forceinline__ void operator()(f32x4 (&acc)[2][2][4][2], const pg8::Unit& u, int wr, int wc, int fr, int fq) const {
        asm volatile("" : "+v"(fr), "+v"(fq));
        const int row0 = u.pm * 256 + wr * 64 + fr, col0 = u.pn * 256 + wc * 32 + 8 * fq;
#pragma unroll
        for (int h2 = 0; h2 < 4; ++h2) {
            const int ai = h2 >> 1, mb = (h2 & 1) * 2;
            u32x4 pre[2][2];
#pragma unroll
            for (int mm = 0; mm < 2; ++mm)
#pragma unroll
                for (int bj = 0; bj < 2; ++bj) pre[mm][bj] = *(const u32x4*)(base + (size_t)(row0 + ai * 128 + (mb + mm) * 16) * ldc + col0 + bj * 128);
#pragma unroll
            for (int mm = 0; mm < 2; ++mm) {
                const int m = mb + mm, row = row0 + ai * 128 + m * 16; float ss = 0.f;
#pragma unroll
                for (int bj = 0; bj < 2; ++bj) {
                    const u32x4 w = pre[mm][bj];
                    const f32x4 o0 = (f32x4){__uint_as_float(w.x << 16), __uint_as_float(w.x & 0xffff0000u), __uint_as_float(w.y << 16), __uint_as_float(w.y & 0xffff0000u)} + acc[ai][bj][m][0];
                    const f32x4 o1 = (f32x4){__uint_as_float(w.z << 16), __uint_as_float(w.z & 0xffff0000u), __uint_as_float(w.w << 16), __uint_as_float(w.w & 0xffff0000u)} + acc[ai][bj][m][1];
                    acc[ai][bj][m][0] = o0; acc[ai][bj][m][1] = o1;
                    ss += ((o0.x * o0.x + o0.y * o0.y) + (o0.z * o0.z + o0.w * o0.w)) + ((o1.x * o1.x + o1.y * o1.y) + (o1.z * o1.z + o1.w * o1.w));
                }
                ss += swz_xor<16>(ss); ss = sum_x32(ss); if (fq == 0) atomicAdd(ssq + row, ss);
            }
        }
        asm volatile("s_waitcnt vmcnt(0)" ::: "memory");
        __builtin_amdgcn_s_barrier();
        if (wr == 0 && wc == 0) {
            unsigned* cw = cnt + 64 * u.pm;
            if (fr == 0 && fq == 0) __hip_atomic_fetch_add(cw, 1u, __ATOMIC_RELAXED, __HIP_MEMORY_SCOPE_AGENT);
            unsigned sp = 0; while (__hip_atomic_load(cw, __ATOMIC_RELAXED, __HIP_MEMORY_SCOPE_AGENT) < 8u && ++sp < (1u << 22)) __builtin_amdgcn_s_sleep(2);
        }
        __builtin_amdgcn_s_barrier();
        float rsv[2][4];
#pragma unroll
        for (int ai = 0; ai < 2; ++ai)
#pragma unroll
            for (int m = 0; m < 4; ++m) rsv[ai][m] = __hip_atomic_load(ssq + row0 + ai * 128 + m * 16, __ATOMIC_RELAXED, __HIP_MEMORY_SCOPE_AGENT);
#pragma unroll
        for (int ai = 0; ai < 2; ++ai)
#pragma unroll
            for (int m = 0; m < 4; ++m) rsv[ai][m] = 1.0f / sqrtf(rsv[ai][m] * (1.0f / DM) + EPS);
#pragma unroll
        for (int bj = 0; bj < 2; ++bj) {
            const f32x4 g0 = *(const f32x4*)(g + col0 + bj * 128), g1 = *(const f32x4*)(g + col0 + bj * 128 + 4);
#pragma unroll
            for (int ai = 0; ai < 2; ++ai)
#pragma unroll
                for (int m = 0; m < 4; ++m) {
                    const size_t off = (size_t)(row0 + ai * 128 + m * 16) * ldc + col0 + bj * 128; const float r = rsv[ai][m];
                    *(f32x4*)(out + off) = acc[ai][bj][m][0] * r * g0; *(f32x4*)(out + off + 4) = acc[ai][bj][m][1] * r * g1;
                }
        }
    }
};

struct TailUnits { int c, G, n, pn; __device__ __forceinline__ bool next(int i, pg8::Unit& u) const { const int pm = c + i * G; if (pm >= n) return false; u.pm = pm; u.pn = pn; return true; } };
template <class Epi, class Sched>
__device__ __forceinline__ void run_gemm_s(LAS unsigned char* lds, const bf16_t* A, int lda, const bf16_t* Bt, int M, int N, int K, const Epi& E, const Sched& S, const int wave_s) {
    pg8::Gemm g{A, Bt, M, N, K, lda};
    pg8::gemm_phase<Epi, Sched>(lds, g, S, E, wave_s);
}
template <class Epi>
__device__ __forceinline__ void run_gemm(LAS unsigned char* lds, const bf16_t* A, int lda, const bf16_t* Bt, int M, int N, int K, const Epi& E, int coff, const int wave_s, const int wgm = 2) {
    pg8::Gemm g{A, Bt, M, N, K, lda}; pg8::StaticOrder S; int cc_ = (int)blockIdx.x + coff; if (cc_ >= (int)gridDim.x) cc_ -= (int)gridDim.x; S.init(M, N, (int)gridDim.x, cc_, wgm);
    pg8::gemm_phase<Epi, pg8::StaticOrder>(lds, g, S, E, wave_s);
}

namespace fa {
typedef float f32x16 __attribute__((ext_vector_type(16)));
typedef short s16x4 __attribute__((ext_vector_type(4)));
constexpr int KMAXB = 24576, VMAXB = 16384;
constexpr int OFF_V = 3 * KMAXB, OFF_SCR = OFF_V + 2 * VMAXB, OFF_STG = 0, OFF_Q = OFF_SCR + 8 * 256, LDS_NEED = OFF_Q + 16;
constexpr float THR = 8.f;
__device__ __forceinline__ s16x4 vtr(const LAS unsigned char* p) { return __builtin_bit_cast(s16x4, __builtin_amdgcn_ds_read_tr16_b64_v4i16((LAS s16x4*)p)); }
__device__ __forceinline__ float silu(float g) { return g * __builtin_amdgcn_rcpf(1.0f + __builtin_amdgcn_exp2f(-1.4426950408889634f * g)); }

template <int MODE>
__device__ __forceinline__ void attn_item(LAS unsigned char* lds, unsigned char* ws, const float* sinks, int item, const int wave) {
    constexpr int DQK = MODE == 0 ? 192 : MODE == 3 ? 64 : 128, DV = MODE == 3 ? 64 : 128;
    constexpr int NKC = DQK / 64, NVC = DV / 64, ND0 = DQK / 16, NDV = DV / 32;
    constexpr int LDH = (MODE <= 2) ? LDH0 : LDH1;
    constexpr bool CAUSAL = (MODE == 0 || MODE == 1), NOMASK = (MODE == 2 || MODE == 5);
    constexpr unsigned WD = CAUSAL ? 0x7fffffffu : (MODE == 3 ? 127u : 128u);
    constexpr float SCALE = MODE == 0 ? 0.07216878364870322f : MODE == 3 ? 0.125f : 0.08838834764831845f;
    constexpr float C2 = SCALE * 1.4426950408889634f;
    int tid = wave * 64 + lane_id(); asm volatile("" : "+v"(tid));
    const int lane = tid & 63, c = lane & 31, hi = lane >> 5;
    bf16_t* H = (bf16_t*)(ws + WS_H);
    const bf16_t* qrow; const bf16_t* kbase; const bf16_t* k2base = nullptr; const bf16_t* vbase; long kstride, vstride, k2stride = 0;
    int qpos, kt_first, nt, blk = 0; long tok0, tokstep = 1; int ycol = 0, hh, pat = 0;
    if (MODE == 0 || MODE == 1) {
        const int qt = 15 - (item >> 5), bh = item & 31, b = bh >> 3; hh = bh & 7; blk = qt;
        tok0 = (long)b * SEQ + 256 * qt + 32 * wave; qpos = 256 * qt + 32 * wave; kt_first = 0; nt = 4 * (qt + 1);
        if (MODE == 0) {
            qrow = (const bf16_t*)sinks + (tok0 + c) * 1536 + hh * 192;
            kbase = (const bf16_t*)(ws + WS_KVA) + (long)b * SEQ * 2048 + hh * 256; kstride = 2048; vbase = kbase + 128; vstride = 2048;
            k2base = H + (long)b * SEQ * LDH0 + E_KPE; k2stride = LDH0; ycol = E_G + hh * 128;
        } else {
            qrow = H + (tok0 + c) * LDH0 + E_QB + hh * 128; kbase = H + (long)b * SEQ * LDH0 + E_KB + hh * 128; vbase = H + (long)b * SEQ * LDH0 + E_VB + hh * 128;
            kstride = vstride = LDH0; ycol = E_G + 1024 + hh * 128;
        }
    } else if (MODE == 2 || MODE == 5) {
        const int b = item >> 6, qt = item & 15; hh = (item >> 4) & 3;
        tok0 = (long)b * SEQ + 256 * qt + 32 * wave; qpos = 0; kt_first = 0; nt = 4;
        const bf16_t* MKV = (const bf16_t*)(ws + (MODE == 2 ? WS_MKVE : WS_MKVO));
        qrow = H + (tok0 + c) * LDH + (MODE == 2 ? E_QM : O_QM) + hh * 128;
        kbase = MKV + (long)b * NMEM * 1024 + hh * 128; vbase = kbase + 512; kstride = vstride = 1024;
        ycol = (MODE == 2 ? E_G + 2048 : O_G + 1792) + hh * 128;
    } else if (MODE == 3) {
        const int b = item >> 8, kvh = (item >> 7) & 1, tt = item & 127, t0 = 32 * tt; hh = kvh * 8 + wave;
        tok0 = (long)b * SEQ + t0; qpos = t0; kt_first = (t0 > 127 ? t0 - 127 : 0) & ~63; nt = ((t0 + 31) >> 6) - (kt_first >> 6) + 1;
        qrow = H + (tok0 + c) * LDH1 + O_QC + hh * 64; kbase = (const bf16_t*)(ws + WS_KC) + ((long)kvh * T + (long)b * SEQ) * 64; vbase = (const bf16_t*)(ws + WS_VC) + ((long)kvh * T + (long)b * SEQ) * 64;
        kstride = vstride = 64; ycol = O_G + hh * 64;
    } else {
        pat = item / 384; const int jj = item - pat * 384; hh = jj % 6; const int rest = jj / 6, b = rest >> 4;
        int r, qt, d;
        if (pat == 0) { r = 0; qt = rest & 15; d = 1; } else if (pat == 1) { r = (rest >> 2) & 3; qt = rest & 3; d = 4; } else { r = rest & 15; qt = 0; d = 16; }
        const long base = (long)b * SEQ + r; qpos = 256 * qt + 32 * wave; tokstep = d; tok0 = base + (long)d * qpos;
        kt_first = qt > 0 ? 256 * qt - 128 : 0; nt = 4 * (qt + 1) - (kt_first >> 6);
        qrow = H + (tok0 + (long)d * c) * LDH1 + O_QD + hh * 128; kbase = (const bf16_t*)(ws + WS_KD) + ((long)hh * T + base) * 128; vbase = (const bf16_t*)(ws + WS_VD) + ((long)hh * T + base) * 128;
        kstride = vstride = (long)d * 128;
    }
    bf16x8 qf[ND0];
#pragma unroll
    for (int d0 = 0; d0 < ND0; ++d0) qf[d0] = *(const bf16x8*)(qrow + 16 * d0 + 8 * hi);
    unsigned selmask = 0;
    if (MODE == 1 && blk > 0) {
        const float* km = (const float*)(ws + WS_KMEAN) + ((size_t)((item & 31) * 16 + (c & 15))) * 128;
        f32x16 G = {0.f, 0.f, 0.f, 0.f, 0.f, 0.f, 0.f, 0.f, 0.f, 0.f, 0.f, 0.f, 0.f, 0.f, 0.f, 0.f};
#pragma unroll
        for (int d0 = 0; d0 < 8; ++d0) {
            f32x4 a = *(const f32x4*)(km + 16 * d0 + 8 * hi), b = *(const f32x4*)(km + 16 * d0 + 8 * hi + 4);
            if (c >= 16) { a = (f32x4){0.f, 0.f, 0.f, 0.f}; b = a; }
            u32x4 wh; wh.x = cvt_pk_bf16(a.x, a.y); wh.y = cvt_pk_bf16(a.z, a.w); wh.z = cvt_pk_bf16(b.x, b.y); wh.w = cvt_pk_bf16(b.z, b.w);
            f32x4 ra, rb;
            ra.x = a.x - __uint_as_float(wh.x << 16); ra.y = a.y - __uint_as_float(wh.x & 0xffff0000u); ra.z = a.z - __uint_as_float(wh.y << 16); ra.w = a.w - __uint_as_float(wh.y & 0xffff0000u);
            rb.x = b.x - __uint_as_float(wh.z << 16); rb.y = b.y - __uint_as_float(wh.z & 0xffff0000u); rb.z = b.z - __uint_as_float(wh.w << 16); rb.w = b.w - __uint_as_float(wh.w & 0xffff0000u);
            u32x4 wl; wl.x = cvt_pk_bf16(ra.x, ra.y); wl.y = cvt_pk_bf16(ra.z, ra.w); wl.z = cvt_pk_bf16(rb.x, rb.y); wl.w = cvt_pk_bf16(rb.z, rb.w);
            G = __builtin_amdgcn_mfma_f32_32x32x16_bf16(__builtin_bit_cast(bf16x8, wh), qf[d0], G, 0, 0, 0);
            G = __builtin_amdgcn_mfma_f32_32x32x16_bf16(__builtin_bit_cast(bf16x8, wl), qf[d0], G, 0, 0, 0);
        }
        float gv[16];
#pragma unroll
        for (int r = 0; r < 8; ++r) { const float own = G[r], oth = xchg_x32(own); const int n0 = (r & 3) + 8 * (r >> 2);
            gv[n0] = hi == 0 ? own : oth; gv[n0 + 4] = hi == 0 ? oth : own; }
        unsigned used = 0;
#pragma unroll
        for (int k = 0; k < 3; ++k) { int best = -1; float bv = -INFINITY;
#pragma unroll
            for (int n = 0; n < 16; ++n) if (!((used >> n) & 1u) && n < blk && (best < 0 || gv[n] > bv)) { best = n; bv = gv[n]; }
            if (best >= 0) used |= 1u << best; }
        selmask = used;
    }
    LAS unsigned char* scrb = lds + OFF_SCR + wave * 256; LAS float* al = (LAS float*)scrb; LAS float* li = al + 32; const LAS float* alh = al + 4 * hi; const LAS float* lih = li + 4 * hi;
    const int kk = wave * 8 + (lane & 7), cc = lane >> 3;
    const int kwr = cc * 1024 + kk * 16;
    int kvr, vwr; long vgo;
    if (DV == 128) { kvr = tid >> 4; const int c16 = tid & 15; vwr = kvr * 256 + ((((c16 >> 2) ^ (kvr & 3))) << 6) + (c16 & 3) * 16; vgo = 8 * c16; }
    else { kvr = tid >> 3; const int c8 = tid & 7; vwr = kvr * 128 + ((((c8 >> 2) ^ ((kvr >> 1) & 1))) << 6) + (c8 & 3) * 16; vgo = 8 * c8; }
    const int krd = hi * 1024 + c * 16;
    const int q4 = (lane & 15) >> 2, p4 = lane & 3, colhalf = (lane >> 4) & 1;
    int vrd, vq[NDV];
    if (DV == 128) { vrd = (4 * hi + q4) * 256 + 32 * colhalf + 8 * p4;
#pragma unroll
        for (int d0 = 0; d0 < NDV; ++d0) vq[d0] = (d0 ^ q4) << 6; }
    else { vrd = (4 * hi + q4) * 128 + 32 * colhalf + 8 * p4;
#pragma unroll
        for (int d0 = 0; d0 < NDV; ++d0) vq[d0] = (d0 ^ ((q4 >> 1) & 1)) << 6; }
    constexpr int VS = DV * 2 * 16, VH = DV * 2 * 8;
    u32x4 kst[NKC], vst[NVC];
    f32x16 o[NDV];
#pragma unroll
    for (int d0 = 0; d0 < NDV; ++d0) o[d0] = (f32x16){0.f, 0.f, 0.f, 0.f, 0.f, 0.f, 0.f, 0.f, 0.f, 0.f, 0.f, 0.f, 0.f, 0.f, 0.f, 0.f};
    float m_reg = -1e30f, l_reg = 0.f;
    constexpr bool SKIPMODE = (MODE == 3 || MODE == 4);
    if constexpr (SKIPMODE) {
#define FA_GLOAD(t) do { const long j0_ = kt_first + 64 * (t); \
        _Pragma("unroll") for (int i_ = 0; i_ < NKC; ++i_) { \
            if (MODE == 0 && i_ == 2) kst[i_] = *(const u32x4*)(k2base + (j0_ + kk) * k2stride + 8 * cc); \
            else kst[i_] = *(const u32x4*)(kbase + (j0_ + kk) * kstride + 8 * (8 * i_ + cc)); } \
        _Pragma("unroll") for (int i_ = 0; i_ < NVC; ++i_) vst[i_] = *(const u32x4*)(vbase + (j0_ + kvr + 32 * i_) * vstride + vgo); } while (0)
#define FA_LWRITE(bf) do { LAS unsigned char* kb_ = lds + (bf) * KMAXB; LAS unsigned char* vb_ = lds + OFF_V + (bf) * VMAXB; \
        _Pragma("unroll") for (int i_ = 0; i_ < NKC; ++i_) *(LAS u32x4*)(kb_ + kwr + i_ * 8192) = kst[i_]; \
        _Pragma("unroll") for (int i_ = 0; i_ < NVC; ++i_) *(LAS u32x4*)(vb_ + vwr + i_ * 8192) = vst[i_]; } while (0)
    FA_GLOAD(0); FA_LWRITE(0);
    __syncthreads();
    for (int t = 0; t < nt; ++t) {
        const int kt0 = kt_first + 64 * t;
        if (t + 1 < nt) FA_GLOAD(t + 1);
        bool act = true, rowmask = false, bandmask = false;
        if (MODE == 1 && t < 4 * blk) { const int n = t >> 2; const bool mine = (selmask >> n) & 1u; act = __ballot(mine) != 0ull; rowmask = true; }
        else if (!NOMASK) {
            act = kt0 <= qpos + 31 && (CAUSAL || kt0 + 63 + (int)WD >= qpos);
            bandmask = !(kt0 + 63 <= qpos && (CAUSAL || kt0 + (int)WD >= qpos + 31));
        }
        if (act) {
            LAS unsigned char* kb = lds + (t & 1) * KMAXB; LAS unsigned char* vb = lds + OFF_V + (t & 1) * VMAXB;
            f32x16 p0 = {0.f, 0.f, 0.f, 0.f, 0.f, 0.f, 0.f, 0.f, 0.f, 0.f, 0.f, 0.f, 0.f, 0.f, 0.f, 0.f}, p1 = p0;
            {
                bf16x8 k0[ND0], k1[ND0];
#pragma unroll
                for (int d0 = 0; d0 < ND0; ++d0) { k0[d0] = *(const LAS bf16x8*)(kb + krd + d0 * 2048); k1[d0] = *(const LAS bf16x8*)(kb + krd + d0 * 2048 + 512); }
#pragma unroll
                for (int d0 = 0; d0 < ND0; ++d0) { p0 = __builtin_amdgcn_mfma_f32_32x32x16_bf16(k0[d0], qf[d0], p0, 0, 0, 0); p1 = __builtin_amdgcn_mfma_f32_32x32x16_bf16(k1[d0], qf[d0], p1, 0, 0, 0); }
                __builtin_amdgcn_sched_group_barrier(0x100, 4, 0);
#pragma unroll
                for (int d0 = 0; d0 < ND0; ++d0) { if (d0 + 2 < ND0) __builtin_amdgcn_sched_group_barrier(0x100, 2, 0); __builtin_amdgcn_sched_group_barrier(0x008, 2, 0); }
            }
            if (rowmask) { if (!((selmask >> (t >> 2)) & 1u)) {
#pragma unroll
                for (int r = 0; r < 16; ++r) { p0[r] = -INFINITY; p1[r] = -INFINITY; } } }
            if (bandmask) { const int dq = qpos + c - kt0 - 4 * hi;
#pragma unroll
                for (int r = 0; r < 16; ++r) { const int cr = (r & 3) + 8 * (r >> 2);
                    if ((unsigned)(dq - cr) > WD) p0[r] = -INFINITY;
                    if ((unsigned)(dq - cr - 32) > WD) p1[r] = -INFINITY; } }
            float pmax = p0[0];
#pragma unroll
            for (int r = 1; r < 16; ++r) pmax = fmaxf(pmax, p0[r]);
#pragma unroll
            for (int r = 0; r < 16; ++r) pmax = fmaxf(pmax, p1[r]);
            pmax = max_x32(pmax);
            if (!__all((pmax - m_reg) * SCALE <= THR)) {
                const float mn = fmaxf(m_reg, pmax), alpha = __builtin_amdgcn_exp2f((m_reg - mn) * C2); m_reg = mn; l_reg *= alpha;
                if (hi == 0) al[c] = alpha;
                asm volatile("s_waitcnt lgkmcnt(0)" ::: "memory");
#pragma unroll
                for (int r = 0; r < 16; ++r) { const float f = alh[(r & 3) + 8 * (r >> 2)];
#pragma unroll
                    for (int d0 = 0; d0 < NDV; ++d0) o[d0][r] *= f; }
                asm volatile("s_waitcnt lgkmcnt(0)" ::: "memory");
            }
            const float mnl = -m_reg * C2; float ps = 0.f;
#pragma unroll
            for (int r = 0; r < 16; ++r) { p0[r] = __builtin_amdgcn_exp2f(fmaf(p0[r], C2, mnl)); p1[r] = __builtin_amdgcn_exp2f(fmaf(p1[r], C2, mnl)); ps += p0[r] + p1[r]; }
            l_reg += ps;
            bf16x8 pa[4];
#pragma unroll
            for (int s = 0; s < 4; ++s) { u32x4 w;
                if (s < 2) { w.x = cvt_pk_bf16(p0[8 * s + 0], p0[8 * s + 1]); w.y = cvt_pk_bf16(p0[8 * s + 2], p0[8 * s + 3]); w.z = cvt_pk_bf16(p0[8 * s + 4], p0[8 * s + 5]); w.w = cvt_pk_bf16(p0[8 * s + 6], p0[8 * s + 7]); }
                else { const int s2 = s - 2; w.x = cvt_pk_bf16(p1[8 * s2 + 0], p1[8 * s2 + 1]); w.y = cvt_pk_bf16(p1[8 * s2 + 2], p1[8 * s2 + 3]); w.z = cvt_pk_bf16(p1[8 * s2 + 4], p1[8 * s2 + 5]); w.w = cvt_pk_bf16(p1[8 * s2 + 6], p1[8 * s2 + 7]); }
                pa[s] = __builtin_bit_cast(bf16x8, w); }
            {
                s16x4 lo[4 * NDV], hv[4 * NDV];
#pragma unroll
                for (int s = 0; s < 4; ++s)
#pragma unroll
                    for (int d0 = 0; d0 < NDV; ++d0) { lo[s * NDV + d0] = vtr(vb + vrd + vq[d0] + s * VS); hv[s * NDV + d0] = vtr(vb + vrd + vq[d0] + s * VS + VH); }
#pragma unroll
                for (int s = 0; s < 4; ++s)
#pragma unroll
                    for (int d0 = 0; d0 < NDV; ++d0) { const s16x4 a_ = lo[s * NDV + d0], b_ = hv[s * NDV + d0];
                        const bf16x8 vf = {a_[0], a_[1], a_[2], a_[3], b_[0], b_[1], b_[2], b_[3]};
                        o[d0] = __builtin_amdgcn_mfma_f32_32x32x16_bf16(pa[s], vf, o[d0], 0, 0, 0); }
                __builtin_amdgcn_sched_group_barrier(0x100, 4, 1);
#pragma unroll
                for (int i = 0; i < 4 * NDV; ++i) { if (i + 2 < 4 * NDV) __builtin_amdgcn_sched_group_barrier(0x100, 2, 1); __builtin_amdgcn_sched_group_barrier(0x008, 1, 1); }
            }
        }
        if (t + 1 < nt) FA_LWRITE((t + 1) & 1);
        __syncthreads();
    }
#undef FA_GLOAD
#undef FA_LWRITE
    } else {
    unsigned kvo[NKC], vvo[NVC];
#pragma unroll
    for (int i_ = 0; i_ < NKC; ++i_) kvo[i_] = (MODE == 0 && i_ == 2) ? (unsigned)(kk * k2stride + 8 * cc) * 2u : (unsigned)(kk * kstride + 8 * (8 * i_ + cc)) * 2u;
#pragma unroll
    for (int i_ = 0; i_ < NVC; ++i_) vvo[i_] = (unsigned)((kvr + 32 * i_) * vstride + vgo) * 2u;
#define FA_GLOAD_K(t) do { const long j0_ = kt_first + 64 * (t); const char* kb0_ = (const char*)(kbase + j0_ * kstride); const char* kb2_ = (const char*)(k2base + j0_ * k2stride); \
        _Pragma("unroll") for (int i_ = 0; i_ < NKC; ++i_) { \
            if (MODE == 0 && i_ == 2) kst[i_] = *(const u32x4*)(kb2_ + kvo[i_]); \
            else kst[i_] = *(const u32x4*)(kb0_ + kvo[i_]); } } while (0)
#define FA_GLOAD_V(t) do { const long j0_ = kt_first + 64 * (t); const char* vb0_ = (const char*)(vbase + j0_ * vstride); \
        _Pragma("unroll") for (int i_ = 0; i_ < NVC; ++i_) vst[i_] = *(const u32x4*)(vb0_ + vvo[i_]); } while (0)
#define FA_LWRITE_K(kofs) do { LAS unsigned char* kb_ = lds + (kofs); \
        _Pragma("unroll") for (int i_ = 0; i_ < NKC; ++i_) *(LAS u32x4*)(kb_ + kwr + i_ * 8192) = kst[i_]; } while (0)
#define FA_LWRITE_V(bf) do { LAS unsigned char* vb_ = lds + OFF_V + (bf) * VMAXB; \
        _Pragma("unroll") for (int i_ = 0; i_ < NVC; ++i_) *(LAS u32x4*)(vb_ + vwr + i_ * 8192) = vst[i_]; } while (0)
#define FA_QK_H(P, kofs, koff) \
        { int ka_ = (kofs) + (koff) + krd; asm volatile("" : "+v"(ka_)); const LAS unsigned char* kb_ = lds + ka_; bf16x8 kf_[ND0]; \
          P = (f32x16){0.f, 0.f, 0.f, 0.f, 0.f, 0.f, 0.f, 0.f, 0.f, 0.f, 0.f, 0.f, 0.f, 0.f, 0.f, 0.f}; \
          _Pragma("unroll") for (int d0 = 0; d0 < ND0; ++d0) kf_[d0] = *(const LAS bf16x8*)(kb_ + d0 * 2048); \
          _Pragma("unroll") for (int d0 = 0; d0 < ND0; ++d0) P = __builtin_amdgcn_mfma_f32_32x32x16_bf16(kf_[d0], qf[d0], P, 0, 0, 0); }
#define FA_KPRE(kofs, koff) \
        { int ka_ = (kofs) + (koff) + krd; asm volatile("" : "+v"(ka_)); const LAS unsigned char* kb_ = lds + ka_; kpre0 = *(const LAS bf16x8*)(kb_); kpre1 = *(const LAS bf16x8*)(kb_ + 2048); }
#define FA_QK_HP(P, kofs, koff) \
        { int ka_ = (kofs) + (koff) + krd; asm volatile("" : "+v"(ka_)); const LAS unsigned char* kb_ = lds + ka_; bf16x8 kf_[ND0]; kf_[0] = kpre0; kf_[1] = kpre1; \
          P = (f32x16){0.f, 0.f, 0.f, 0.f, 0.f, 0.f, 0.f, 0.f, 0.f, 0.f, 0.f, 0.f, 0.f, 0.f, 0.f, 0.f}; \
          _Pragma("unroll") for (int d0 = 2; d0 < ND0; ++d0) kf_[d0] = *(const LAS bf16x8*)(kb_ + d0 * 2048); \
          _Pragma("unroll") for (int d0 = 0; d0 < ND0; ++d0) P = __builtin_amdgcn_mfma_f32_32x32x16_bf16(kf_[d0], qf[d0], P, 0, 0, 0); }
#define FA_VPRE(bf, s0) \
        { int a0_ = OFF_V + (bf) * VMAXB + (s0) * VS + vrd + vq[0], a1_ = OFF_V + (bf) * VMAXB + (s0) * VS + vrd + vq[1]; asm volatile("" : "+v"(a0_), "+v"(a1_)); \
          vplo0 = vtr(lds + a0_); vphv0 = vtr(lds + a0_ + VH); vplo1 = vtr(lds + a1_); vphv1 = vtr(lds + a1_ + VH); }
#define FA_PV_HP(bf, s0) \
        { s16x4 lo_[2 * NDV], hv_[2 * NDV]; const LAS unsigned char* vbd_[NDV]; \
          _Pragma("unroll") for (int d0 = 0; d0 < NDV; ++d0) { int a_ = OFF_V + (bf) * VMAXB + (s0) * VS + vrd + vq[d0]; asm volatile("" : "+v"(a_)); vbd_[d0] = lds + a_; } \
          lo_[0] = vplo0; hv_[0] = vphv0; lo_[1] = vplo1; hv_[1] = vphv1; \
          _Pragma("unroll") for (int s_ = 0; s_ < 2; ++s_) _Pragma("unroll") for (int d0 = 0; d0 < NDV; ++d0) { if (s_ * NDV + d0 >= 2) { lo_[s_ * NDV + d0] = vtr(vbd_[d0] + s_ * VS); hv_[s_ * NDV + d0] = vtr(vbd_[d0] + s_ * VS + VH); } } \
          _Pragma("unroll") for (int s_ = 0; s_ < 2; ++s_) _Pragma("unroll") for (int d0 = 0; d0 < NDV; ++d0) { const s16x4 a_ = lo_[s_ * NDV + d0], b_ = hv_[s_ * NDV + d0]; \
              const bf16x8 vf_ = {a_[0], a_[1], a_[2], a_[3], b_[0], b_[1], b_[2], b_[3]}; o[d0] = __builtin_amdgcn_mfma_f32_32x32x16_bf16(pa[s_], vf_, o[d0], 0, 0, 0); } }
#define FA_QKP_EXP_SGB \
        { constexpr int NV_ = (50 + ND0 - 1) / ND0, NT_ = (16 + ND0 - 1) / ND0; \
          _Pragma("unroll") for (int d0 = 0; d0 < ND0; ++d0) { if (d0 + 2 < ND0) __builtin_amdgcn_sched_group_barrier(0x100, 1, 0); __builtin_amdgcn_sched_group_barrier(0x008, 1, 0); \
              __builtin_amdgcn_sched_group_barrier(0x002, NV_, 0); __builtin_amdgcn_sched_group_barrier(0x400, NT_, 0); } \
          __builtin_amdgcn_sched_group_barrier(0x100, 4, 0); }
#define FA_PVP_SGB \
        { _Pragma("unroll") for (int i_ = 0; i_ < 2 * NDV; ++i_) { if (i_ + 2 < 2 * NDV) __builtin_amdgcn_sched_group_barrier(0x100, 2, 1); __builtin_amdgcn_sched_group_barrier(0x008, 1, 1); } \
          __builtin_amdgcn_sched_group_barrier(0x100, 2, 1); }
#define FA_QK_SGB \
        { __builtin_amdgcn_sched_group_barrier(0x100, 2, 0); \
          _Pragma("unroll") for (int d0 = 0; d0 < ND0; ++d0) { if (d0 + 2 < ND0) __builtin_amdgcn_sched_group_barrier(0x100, 1, 0); __builtin_amdgcn_sched_group_barrier(0x008, 1, 0); } }
#define FA_QK_EXP_SGB \
        { constexpr int NV_ = (48 + ND0 - 1) / ND0, NT_ = (16 + ND0 - 1) / ND0; \
          __builtin_amdgcn_sched_group_barrier(0x100, 2, 0); \
          _Pragma("unroll") for (int d0 = 0; d0 < ND0; ++d0) { if (d0 + 2 < ND0) __builtin_amdgcn_sched_group_barrier(0x100, 1, 0); __builtin_amdgcn_sched_group_barrier(0x008, 1, 0); \
              __builtin_amdgcn_sched_group_barrier(0x002, NV_, 0); __builtin_amdgcn_sched_group_barrier(0x400, NT_, 0); } }
#define FA_EXP_H(P) \
        { const float mnl_ = -m_reg * C2; float ps_ = 0.f; \
          _Pragma("unroll") for (int r = 0; r < 16; ++r) { P[r] = __builtin_amdgcn_exp2f(fmaf(P[r], C2, mnl_)); ps_ += P[r]; } \
          l_reg += ps_; \
          _Pragma("unroll") for (int s_ = 0; s_ < 2; ++s_) { u32x4 w_; \
              w_.x = cvt_pk_bf16(P[8 * s_ + 0], P[8 * s_ + 1]); w_.y = cvt_pk_bf16(P[8 * s_ + 2], P[8 * s_ + 3]); w_.z = cvt_pk_bf16(P[8 * s_ + 4], P[8 * s_ + 5]); w_.w = cvt_pk_bf16(P[8 * s_ + 6], P[8 * s_ + 7]); pa[s_] = __builtin_bit_cast(bf16x8, w_); } }
#define FA_MASK_H(P, tt, hh) \
        { const int tt_ = (tt); bool rowm_ = false, bandm_ = false; const int kt0_ = kt_first + 64 * tt_; \
          if (MODE == 1 && tt_ < 4 * blk) rowm_ = true; else if (!NOMASK) bandm_ = !(kt0_ + 63 <= qpos && (CAUSAL || kt0_ + (int)WD >= qpos + 31)); \
          if (rowm_) { if (!((selmask >> (tt_ >> 2)) & 1u)) { _Pragma("unroll") for (int r = 0; r < 16; ++r) P[r] = -INFINITY; } } \
          if (bandm_) { const int dq_ = qpos + c - kt0_ - 4 * hi - 32 * (hh); \
              _Pragma("unroll") for (int r = 0; r < 16; ++r) { if ((unsigned)(dq_ - ((r & 3) + 8 * (r >> 2))) > WD) P[r] = -INFINITY; } } }
#define FA_MAX_H(P, PM) \
        { float pm_ = fmaxf(P[0], P[1]); \
          _Pragma("unroll") for (int r = 2; r < 16; r += 2) pm_ = fmaxf(fmaxf(pm_, P[r]), P[r + 1]); \
          auto rr_ = __builtin_amdgcn_permlane32_swap(__float_as_uint(pm_), __float_as_uint(pm_), false, false); PM = fmaxf(__uint_as_float(rr_[0]), __uint_as_float(rr_[1])); }
#define FA_DECIDE(PM) \
        { if (!__all(((PM) - m_reg) * SCALE <= THR)) { \
              const float mn_ = fmaxf(m_reg, (PM)), alpha_ = __builtin_amdgcn_exp2f((m_reg - mn_) * C2); m_reg = mn_; l_reg *= alpha_; \
              if (hi == 0) al[c] = alpha_; \
              asm volatile("s_waitcnt lgkmcnt(0)" ::: "memory"); \
              _Pragma("unroll") for (int r = 0; r < 16; ++r) { const float f_ = alh[(r & 3) + 8 * (r >> 2)]; \
                  _Pragma("unroll") for (int d0 = 0; d0 < NDV; ++d0) o[d0][r] *= f_; } \
              asm volatile("s_waitcnt lgkmcnt(0)" ::: "memory"); } }
#define FA_PV_H(bf, s0) \
        { s16x4 lo_[2 * NDV], hv_[2 * NDV]; const LAS unsigned char* vbd_[NDV]; \
          _Pragma("unroll") for (int d0 = 0; d0 < NDV; ++d0) { int a_ = OFF_V + (bf) * VMAXB + (s0) * VS + vrd + vq[d0]; asm volatile("" : "+v"(a_)); vbd_[d0] = lds + a_; }     \
          _Pragma("unroll") for (int s_ = 0; s_ < 2; ++s_) _Pragma("unroll") for (int d0 = 0; d0 < NDV; ++d0) { lo_[s_ * NDV + d0] = vtr(vbd_[d0] + s_ * VS); hv_[s_ * NDV + d0] = vtr(vbd_[d0] + s_ * VS + VH); } \
          _Pragma("unroll") for (int s_ = 0; s_ < 2; ++s_) _Pragma("unroll") for (int d0 = 0; d0 < NDV; ++d0) { const s16x4 a_ = lo_[s_ * NDV + d0], b_ = hv_[s_ * NDV + d0]; \
              const bf16x8 vf_ = {a_[0], a_[1], a_[2], a_[3], b_[0], b_[1], b_[2], b_[3]}; o[d0] = __builtin_amdgcn_mfma_f32_32x32x16_bf16(pa[s_], vf_, o[d0], 0, 0, 0); } \
          __builtin_amdgcn_sched_group_barrier(0x100, 4, 1); \
          _Pragma("unroll") for (int i_ = 0; i_ < 2 * NDV; ++i_) { if (i_ + 2 < 2 * NDV) __builtin_amdgcn_sched_group_barrier(0x100, 2, 1); __builtin_amdgcn_sched_group_barrier(0x008, 1, 1); } }
    {
        f32x16 pA, pB;
        bf16x8 kpre0, kpre1; s16x4 vplo0, vphv0, vplo1, vphv1;
        FA_GLOAD_K(0); FA_GLOAD_V(0); FA_LWRITE_K(0); FA_LWRITE_V(0);
        if (nt > 1) { FA_GLOAD_K(1); FA_LWRITE_K(KMAXB); }
        __syncthreads();
        { FA_QK_H(pA, 0, 0) FA_QK_SGB }
        float pmA, pmB;
        FA_MASK_H(pA, 0, 0)
        FA_MAX_H(pA, pmA)
        FA_KPRE(0, 512)
        int kc = 0, kn = KMAXB, kw = 2 * KMAXB;
        const int ntw = CAUSAL ? nt - 3 + (wave >> 1) : nt;
        for (int t = 0; t < nt; ++t) {
            if (t + 2 < nt) FA_GLOAD_K(t + 2);
            if (t + 1 < nt) FA_GLOAD_V(t + 1);
            if (t < ntw) {
            bf16x8 pa[2];
            FA_DECIDE(pmA)
            __builtin_amdgcn_sched_barrier(0);
            { FA_QK_HP(pB, kc, 512) FA_EXP_H(pA) FA_VPRE(t & 1, 0) FA_QKP_EXP_SGB }
            __builtin_amdgcn_sched_barrier(0);
            FA_MASK_H(pB, t, 1)
            __builtin_amdgcn_sched_barrier(0);
            { FA_PV_HP(t & 1, 0) FA_MAX_H(pB, pmB) FA_KPRE(kn, 0) FA_PVP_SGB }
            __builtin_amdgcn_sched_barrier(0);
            FA_DECIDE(pmB)
            __builtin_amdgcn_sched_barrier(0);
            if (t + 1 < ntw) { FA_QK_HP(pA, kn, 0) FA_EXP_H(pB) FA_VPRE(t & 1, 2) FA_QKP_EXP_SGB }
            else { FA_EXP_H(pB) FA_VPRE(t & 1, 2) }
            __builtin_amdgcn_sched_barrier(0);
            if (t + 1 < ntw) FA_MASK_H(pA, t + 1, 0)
            __builtin_amdgcn_sched_barrier(0);
            { FA_PV_HP(t & 1, 2) FA_MAX_H(pA, pmA) FA_KPRE(kn, 512) FA_PVP_SGB }
            __builtin_amdgcn_sched_barrier(0);
            }
            if (t + 2 < nt) FA_LWRITE_K(kw);
            if (t + 1 < nt) FA_LWRITE_V((t + 1) & 1);
            __syncthreads();
            { const int tmp_ = kc; kc = kn; kn = kw; kw = tmp_; }
        }
    }
#undef FA_GLOAD_K
#undef FA_GLOAD_V
#undef FA_LWRITE_K
#undef FA_LWRITE_V
#undef FA_QK_H
#undef FA_QK_SGB
#undef FA_KPRE
#undef FA_QK_HP
#undef FA_VPRE
#undef FA_PV_HP
#undef FA_QKP_EXP_SGB
#undef FA_PVP_SGB
#undef FA_QK_EXP_SGB
#undef FA_EXP_H
#undef FA_MASK_H
#undef FA_MAX_H
#undef FA_DECIDE
#undef FA_PV_H
    }
    constexpr int CPR = DV / 8, NGI = 32 * CPR / 64;
    u32x4 gpre[NGI];
    if (MODE != 4) {
#pragma unroll
        for (int i = 0; i < NGI; ++i) { const int q = lane + 64 * i, row = q / CPR, ch = q % CPR; gpre[i] = *(const u32x4*)(H + (tok0 + tokstep * row) * LDH + ycol + ch * 8); }
    }
    const float lt = sum_x32(l_reg);
    float fin = 1.0f / lt;
    const float lse = m_reg * SCALE + __logf(lt);
    if (MODE == 3) fin *= 1.0f / (1.0f + __expf(sinks[hh] - lse));
    if (hi == 0) li[c] = fin;
    asm volatile("s_waitcnt lgkmcnt(0)" ::: "memory");
    LAS bf16_t* stg = (LAS bf16_t*)(lds + OFF_STG + wave * 8192); LAS bf16_t* stgl = stg + 4 * hi * DV + c;
#pragma unroll
    for (int r = 0; r < 16; ++r) { const int cr = (r & 3) + 8 * (r >> 2); const float f = lih[cr];
#pragma unroll
        for (int d0 = 0; d0 < NDV; ++d0) stgl[cr * DV + 32 * d0] = (bf16_t)(cvt_pk_bf16(o[d0][r] * f, 0.f) & 0xffffu); }
    asm volatile("s_waitcnt lgkmcnt(0)" ::: "memory");
#pragma unroll
    for (int i = 0; i < NGI; ++i) {
        const int q = lane + 64 * i, row = q / CPR, ch = q % CPR;
        const u32x4 v = *(const LAS u32x4*)(stg + row * DV + ch * 8);
        const long tok = tok0 + tokstep * row;
        if (MODE == 4) { *(u32x4*)((bf16_t*)(ws + ws_op(pat)) + (size_t)tok * 768 + hh * 128 + ch * 8) = v; }
        else {
            bf16_t* yp = H + tok * LDH + ycol + ch * 8; const u32x4 g = gpre[i]; u32x4 w;
#define FA_GATE(vv, gg) cvt_pk_bf16(__uint_as_float((vv) << 16) * silu(__uint_as_float((gg) << 16)), __uint_as_float((vv) & 0xffff0000u) * silu(__uint_as_float((gg) & 0xffff0000u)))
            w.x = FA_GATE(v.x, g.x); w.y = FA_GATE(v.y, g.y); w.z = FA_GATE(v.z, g.z); w.w = FA_GATE(v.w, g.w);
#undef FA_GATE
            *(u32x4*)yp = w;
        }
    }
    if (MODE == 4 && hi == 0) ((float*)(ws + WS_LSE))[((size_t)pat * T + tok0 + tokstep * c) * 6 + hh] = lse;
}
}

#define XB_TMO      128
#define XB_XCNT(j)  (256  + 64 * (j))
#define XB_XSUB(j)  (1280 + 64 * (j))
#define XB_XGEN(j)  (2304 + 64 * (j))
#define XB_TOP      3328
#define XB_TOPGEN   3392
#define XCD_BAR_WORDS 3456
#define XB_SPIN_CAP (1u << 22)
__device__ __forceinline__ unsigned xb_ld(unsigned* p)              { return __hip_atomic_load(p, __ATOMIC_RELAXED, __HIP_MEMORY_SCOPE_AGENT); }
__device__ __forceinline__ unsigned xb_add(unsigned* p, unsigned v) { return __hip_atomic_fetch_add(p, v, __ATOMIC_RELAXED, __HIP_MEMORY_SCOPE_AGENT); }
__device__ __forceinline__ unsigned xb_xcc_id() { return (unsigned)__builtin_amdgcn_s_getreg((3 << 11) | 20) & 0xFu; }
#define XB_SPIN(cond, bar) do { unsigned _sp = 0; while (cond) { __builtin_amdgcn_s_sleep(1); \
    if ((++_sp & 255u) == 0u) { if (xb_ld(&(bar)[XB_TMO])) break; if (_sp > XB_SPIN_CAP) { atomicAdd(&(bar)[XB_TMO], 1u); break; } } } } while (0)
__device__ __forceinline__ void xcd_barrier_complete(unsigned* bar, unsigned x, unsigned& nloc, unsigned& nx) {
    const unsigned G = gridDim.x; unsigned sum, cnt, mine, sp = 0u;
    for (;;) {
        sum = 0u; cnt = 0u; mine = 0u;
#pragma unroll
        for (unsigned j = 0; j < 16; ++j) { const unsigned c = xb_ld(&bar[XB_XCNT(j)]); sum += c; cnt += (c > 0u) ? 1u : 0u; mine = (j == x) ? c : mine; }
        if (sum == G) break;
        __builtin_amdgcn_s_sleep(1);
        if ((++sp & 255u) == 0u) { if (xb_ld(&bar[XB_TMO])) break; if (sp > XB_SPIN_CAP) { atomicAdd(&bar[XB_TMO], 1u); break; } }
    }
    nloc = mine > 0u ? mine : 1u; nx = cnt > 0u ? cnt : 1u;
}
__device__ __forceinline__ void grid_barrier(unsigned* bar, volatile LAS unsigned* st, const int wave_s) {
    asm volatile("s_waitcnt vmcnt(0)" ::: "memory");
    __syncthreads();
    if (wave_s == 0 && lane_id() == 0) {
        const unsigned x = xb_xcc_id();
        __builtin_amdgcn_s_waitcnt(0);
        unsigned nloc = st[0], nx = st[1];
        if (nloc == 0u) { xcd_barrier_complete(bar, x, nloc, nx); st[0] = nloc; st[1] = nx; }
        const unsigned old = xb_add(&bar[XB_XSUB(x)], 1u);
        const unsigned gen = old / nloc;
        if (old + 1u == (gen + 1u) * nloc) {
            __builtin_amdgcn_fence(__ATOMIC_RELEASE, "agent");
            asm volatile("s_waitcnt vmcnt(0)" ::: "memory");
            const unsigned og = xb_add(&bar[XB_TOP], 1u);
            const unsigned tg = og / nx;
            if (og + 1u == (tg + 1u) * nx) {
#pragma unroll
                for (unsigned j = 0; j < 16; ++j) (void)xb_add(&bar[XB_XGEN(j)], 1u);
            } else XB_SPIN(xb_ld(&bar[XB_XGEN(x)]) == gen, bar);
            __builtin_amdgcn_fence(__ATOMIC_ACQUIRE, "agent");
            asm volatile("s_waitcnt vmcnt(0)" ::: "memory");
        } else {
            XB_SPIN(xb_ld(&bar[XB_XGEN(x)]) == gen, bar);
            __builtin_amdgcn_fence(__ATOMIC_ACQUIRE, "agent");
            asm volatile("s_waitcnt vmcnt(0)" ::: "memory");
        }
    }
    __syncthreads();
}

__device__ __forceinline__ int opaque_tid(int wave_s) { int t = wave_s * 64 + lane_id(); asm volatile("" : "+v"(t)); return t; }

constexpr int LDS_BYTES = 155648;
static_assert(fa::LDS_NEED <= LDS_BYTES - 64, "LDS map");
__global__ void __launch_bounds__(512, 2) mega(Args args) {
    extern __shared__ __attribute__((aligned(16))) unsigned char lds_raw[];
    LAS unsigned char* lds = (LAS unsigned char*)lds_raw;
    const int G = gridDim.x, NGW = G * 8;
    const int wave_s = __builtin_amdgcn_readfirstlane((int)threadIdx.x >> 6);
#define PHASE_IDS const int tid = opaque_tid(wave_s), lane = tid & 63, wave = wave_s, gw = blockIdx.x * 8 + wave; (void)lane; (void)gw;
#define KA() ({ auto p_ = __builtin_amdgcn_kernarg_segment_ptr(); asm volatile("" : "+s"(p_)); (const __attribute__((address_space(4))) Args*)p_; })
    unsigned char* ws = KA()->ws;
    const int lo = KA()->ph_lo, hi = KA()->ph_hi;
#define IN(k) (lo <= (k) && (k) < hi)
#define SEAM(k) do { if (IN(k) && IN((k) + 1)) { grid_barrier((unsigned*)(ws + WS_CTL) + 1024, (volatile LAS unsigned*)(lds + LDS_BYTES - 64), wave_s); } } while (0)
    if (lane_id() < 16 && wave_s == 0) ((LAS unsigned*)(lds + LDS_BYTES - 64))[lane_id()] = 0u;
    __syncthreads();
    if (hi - lo > 1 && wave_s == 0 && lane_id() == 0) (void)xb_add((unsigned*)(ws + WS_CTL) + 1024 + XB_XCNT(xb_xcc_id()), 1u);
    if (lo < 0) cg::this_grid().sync();
#define W1E ((bf16_t*)(ws + WS_W1E))
#define WUQ ((bf16_t*)(ws + WS_WUQ))
#define WUKV ((bf16_t*)(ws + WS_WUKV))
#define WMKE ((bf16_t*)(ws + WS_WMKE))
#define WOE ((bf16_t*)(ws + WS_WOE))
#define W1O ((bf16_t*)(ws + WS_W1O))
#define WMKO ((bf16_t*)(ws + WS_WMKO))
#define WOO ((bf16_t*)(ws + WS_WOO))
#define XB ((bf16_t*)(ws + WS_R1))
#define QA ((bf16_t*)KA()->out)
#define KVA ((bf16_t*)(ws + WS_KVA))
#define H ((bf16_t*)(ws + WS_H))
#define MEMB ((bf16_t*)(ws + WS_MEMB))
#define MKVE ((bf16_t*)(ws + WS_MKVE))
#define MKVO ((bf16_t*)(ws + WS_MKVO))
#define CS64 ((f32x2*)(ws + WS_CS64))
#define CS32 ((f32x2*)(ws + WS_CS32))
#define CS16 ((f32x2*)(ws + WS_CS16))
#define RS0 ((float*)(ws + WS_RS0))
#define SSQQ ((float*)(ws + WS_SSQQ))
#define SSQKV ((float*)(ws + WS_SSQKV))
#define SSQ1 ((float*)(ws + WS_SSQ1))
#define SSQ2 ((float*)(ws + WS_SSQ2))
#define RSMEM ((float*)(ws + WS_RSMEM))
#define KMEAN ((float*)(ws + WS_KMEAN))
    if (IN(0)) {
        PHASE_IDS
        LAS float* scr = (LAS float*)(lds + wave * 16640);
        constexpr int I0 = 32 * 112, I1 = 8 * 24, I2 = 4 * 32, I3 = 32 * 16, I6 = 32 * 16;
        constexpr int total = I0 + I1 + I2 + I3 + I6;
        for (int it = gw; it < total; it += NGW) {
            int r = it;
            if (r < I0) { transpose_item(KA()->in[3], 2048, 6976, W1E, KA()->in[2], 0, scr, r, 112, lane); continue; } r -= I0;
            if (r < I1) { transpose_item(KA()->in[5], 512, 1536, WUQ, KA()->in[4], 1, scr, r, 24, lane); continue; } r -= I1;
            if (r < I2) { transpose_item(KA()->in[7], 256, 2048, WUKV, KA()->in[6], 2, scr, r, 32, lane); continue; } r -= I2;
            if (r < I3) { transpose_item(KA()->in[9], 2048, 1024, WMKE, KA()->in[8], 3, scr, r, 16, lane); continue; } r -= I3;
            transpose_item(KA()->in[15], 2048, 1024, WMKO, KA()->in[14], 6, scr, r, 16, lane);
        }
        for (int m = gw - total % NGW + (gw < total % NGW ? NGW : 0); m < T + NB * NMEM; m += NGW) {
            if (m < T) row_to_bf16(KA()->in[0] + (size_t)m * DM, XB + (size_t)m * DM, RS0 + m, lane);
            else { const int mm = m - T; row_to_bf16(KA()->in[1] + (size_t)mm * DM, MEMB + (size_t)mm * DM, RSMEM + mm, lane); }
        }
        const int gt = blockIdx.x * 512 + tid, NGT = G * 512;
        for (int i = gt; i < SEQ * 56; i += NGT) {
            const int pos = i / 56, j = i - pos * 56; int rot, fi; f32x2* dst;
            if (j < 32) { rot = 64; fi = j; dst = CS64 + pos * 32 + fi; } else if (j < 48) { rot = 32; fi = j - 32; dst = CS32 + pos * 16 + fi; } else { rot = 16; fi = j - 48; dst = CS16 + pos * 8 + fi; }
            const float inv = 1.0f / powf(500000.0f, (float)(2 * fi) / (float)rot);
            const float ang = (float)pos * inv; float sn, cs; sincosf(ang, &sn, &cs);
            *dst = (f32x2){cs, sn};
        }
        for (int i = gt; i < T; i += NGT) { SSQQ[i] = 0.f; SSQKV[i] = 0.f; SSQ1[i] = 0.f; SSQ2[i] = 0.f; }
        if (gt < 64) ((unsigned*)(ws + WS_CTL))[gt] = 0u;
    }
    SEAM(0);
    if (IN(1)) {
        EpiBF<0> E{H, LDH0, RS0, nullptr, 0.f, SSQQ, SSQKV, CS64, CS32, CS16};
        run_gemm(lds, XB, DM, W1E, T, LDH0, DM, E, 0, wave_s);
    }
    SEAM(1);
    if (IN(2)) {
        PHASE_IDS
        for (int it0 = (int)blockIdx.x * 2; it0 < 512; it0 += G * 2) {
            const int it = it0 + (wave >> 2), q = wave & 3;
            const int b = it >> 7, n = (it >> 3) & 15, hh = it & 7;
            const bf16_t* kp = H + (size_t)(b * SEQ + n * 256 + q * 64) * LDH0 + E_KB + hh * 128 + 2 * lane; float s0 = 0.f, s1 = 0.f;
#pragma unroll 16
            for (int j = 0; j < 64; ++j) { const unsigned w = *(const unsigned*)(kp + (size_t)j * LDH0); s0 += __uint_as_float(w << 16); s1 += __uint_as_float(w & 0xffff0000u); }
            LAS float* part = (LAS float*)lds + wave * 128; part[2 * lane] = s0; part[2 * lane + 1] = s1;
            __syncthreads();
            if (q == 0) {
                const LAS float* p0 = (const LAS float*)lds + wave * 128 + 2 * lane;
                const float t0 = ((p0[0] + p0[128]) + p0[256]) + p0[384], t1 = ((p0[1] + p0[129]) + p0[257]) + p0[385];
                float* km = KMEAN + ((size_t)((b * 8 + hh) * 16 + n)) * 128 + 2 * lane; km[0] = t0 * (1.f / 256.f); km[1] = t1 * (1.f / 256.f);
            }
            __syncthreads();
        }
        { EpiBF<4> E{MKVE, 1024, RSMEM, nullptr, 0.f, nullptr, nullptr, CS64, CS32, CS16}; run_gemm(lds, MEMB, DM, WMKE, NB * NMEM, 1024, DM, E, 0, wave_s); }
        { EpiBF<4> E{MKVO, 1024, RSMEM, nullptr, 0.f, nullptr, nullptr, CS64, CS32, CS16}; run_gemm(lds, MEMB, DM, WMKO, NB * NMEM, 1024, DM, E, 240, wave_s); }
        { EpiBF<1> E{QA, 1536, nullptr, SSQQ, 1.f / 512.f, nullptr, nullptr, CS64, CS32, CS16}; pg8::StaticOrder S; S.init(T, 1536, G == 256 ? 224 : G, G == 256 ? (int)blockIdx.x - 32 : (int)blockIdx.x); run_gemm_s(lds, H + E_CQ, LDH0, WUQ, T, 1536, 512, E, S, wave_s); }
                { EpiBF<2> E{KVA, 2048, nullptr, SSQKV, 1.f / 256.f, nullptr, nullptr, CS64, CS32, CS16};
          pg8::StaticOrder S; int c2 = (int)blockIdx.x;
          if (G == 256) { c2 -= 32; if (c2 >= 0) c2 = c2 >= 160 ? c2 - 160 : c2 + 64; }
          S.init(T, 2048, G == 256 ? 224 : G, c2); run_gemm_s(lds, H + E_CKV, LDH0, WUKV, T, 2048, 256, E, S, wave_s); }
    }
    SEAM(2);
    if (IN(3)) {
        PHASE_IDS
        unsigned* ctr = (unsigned*)(ws + WS_CTL); volatile LAS unsigned* qw = (volatile LAS unsigned*)(lds + fa::OFF_Q);
        for (;;) {
            if (tid == 0) qw[0] = atomicAdd(ctr, 1u);
            __syncthreads();
            const int it = __builtin_amdgcn_readfirstlane((int)qw[0]);
            __syncthreads();
            if (it >= 1280 + 704) break;
            int ia = it, ic = -1;
            if (it >= 256) { const int j = it - 256, blk = j / 27, r = j - blk * 27, nc = (r * 11) / 27; if (((r + 1) * 11) / 27 > nc) ic = blk * 11 + nc; else ia = 256 + blk * 16 + (r - nc); }
            if (ic >= 0) {
                constexpr int I4 = 40 * 32, I5 = 32 * 100;
                LAS float* scr = (LAS float*)(lds + (wave < 6 ? wave * 16640 : 108800 + (wave - 6) * 16640));
                int r = ic * 8 + wave;
                int ln = lane_id(); asm volatile("" : "+v"(ln));
                if (r < I4) transpose_item(KA()->in[10], 2560, 2048, WOE, nullptr, 4, scr, r, 32, ln);
                else if (r < I4 + I5) transpose_item(KA()->in[12], 2048, 6400, W1O, KA()->in[11], 5, scr, r - I4, 100, ln);
                else transpose_item(KA()->in[16], 2304, 2048, WOO, nullptr, 7, scr, r - I4 - I5, 32, ln);
                continue;
            }
            if (ia < 1024) { const int item = (ia & ~63) / 2 + (ia & 31); if (((ia >> 5) & 1) == 0) fa::attn_item<0>(lds, ws, (const float*)KA()->out, item, wave_s); else fa::attn_item<1>(lds, ws, KA()->in[13], item, wave_s); }
            else fa::attn_item<2>(lds, ws, KA()->in[13], ia - 1024, wave_s);
        }
    }
    SEAM(3);
    if (IN(4)) {
        EpiRes<true, false> E{XB, nullptr, XB, DM, SSQ1};
        run_gemm(lds, H + E_G, LDH0, WOE, T, DM, 2560, E, 0, wave_s, WGM_OUT);
    }
    SEAM(4);
    if (IN(5)) {
        EpiBF<3> E{H, LDH1, nullptr, SSQ1, 1.f / DM, nullptr, nullptr, CS64, CS32, CS16};
        run_gemm(lds, XB, DM, W1O, T, 6144, DM, E, 0, wave_s);
    }
    SEAM(5);
    if (IN(6)) {
        PHASE_IDS
        if (blockIdx.x < 64) {
            EpiBF<3> E{H, LDH1, nullptr, SSQ1, 1.f / DM, nullptr, nullptr, CS64, CS32, CS16}; TailUnits S1{(int)blockIdx.x, G, 64, 24};
            run_gemm_s(lds, XB, DM, W1O, T, LDH1, DM, E, S1, wave_s);
            asm volatile("s_waitcnt vmcnt(0)" ::: "memory"); __syncthreads();
            if (tid == 0) { __builtin_amdgcn_fence(__ATOMIC_RELEASE, "agent"); asm volatile("s_waitcnt vmcnt(0)" ::: "memory"); __hip_atomic_fetch_add((unsigned*)(ws + WS_CTL) + 32, (unsigned)((64 - (int)blockIdx.x + G - 1) / G), __ATOMIC_RELAXED, __HIP_MEMORY_SCOPE_AGENT); }
        }
        unsigned* ctr = (unsigned*)(ws + WS_CTL) + 16; volatile LAS unsigned* qw = (volatile LAS unsigned*)(lds + fa::OFF_Q);
        unsigned nxt_ = 0u; if (tid == 0) nxt_ = atomicAdd(ctr, 1u);
        for (;;) {
            if (tid == 0) qw[0] = nxt_;
            __syncthreads();
            const int it = __builtin_amdgcn_readfirstlane((int)qw[0]);
            __syncthreads();
            if (it >= 1152 + 256 + 1024) break;
            if (tid == 0) nxt_ = atomicAdd(ctr, 1u);
            unsigned* tailcnt = (unsigned*)(ws + WS_CTL) + 32;
            const int it2 = it;
            if (it2 < 1152) fa::attn_item<4>(lds, ws, KA()->in[13], it2, wave_s);
            else if (it2 < 1408) {
                if (((it2 - 1152) >> 4) & 2) {
                    if (tid == 0) { unsigned sp = 0; while (__hip_atomic_load(tailcnt, __ATOMIC_RELAXED, __HIP_MEMORY_SCOPE_AGENT) < 64u && ++sp < (1u << 24)) __builtin_amdgcn_s_sleep(4);
                                    __builtin_amdgcn_fence(__ATOMIC_ACQUIRE, "agent"); asm volatile("s_waitcnt vmcnt(0)" ::: "memory"); }
                    __syncthreads();
                }
                fa::attn_item<5>(lds, ws, KA()->in[13], it2 - 1152, wave_s);
            }
            else fa::attn_item<3>(lds, ws, KA()->in[13], it2 - 1408, wave_s);
        }
    }
    SEAM(6);
    if (IN(7)) {
        PHASE_IDS
        const bf16_t* OP0 = (const bf16_t*)(ws + ws_op(0)); const bf16_t* OP1 = (const bf16_t*)(ws + ws_op(1)); const bf16_t* OP2 = (const bf16_t*)(ws + ws_op(2)); const float* LSE = (const float*)(ws + WS_LSE);
        for (int q = blockIdx.x * 512 + tid; q < T * 96; q += G * 512) {
            const int tok = q / 96, ch = q - tok * 96, hd = ch >> 4;
            const float l0 = LSE[(size_t)tok * 6 + hd], l1 = LSE[((size_t)T + tok) * 6 + hd], l2 = LSE[((size_t)2 * T + tok) * 6 + hd];
            const float mx = fmaxf(l0, fmaxf(l1, l2)); float w0 = __expf(l0 - mx), w1 = __expf(l1 - mx), w2 = __expf(l2 - mx); const float iw = 1.0f / (w0 + w1 + w2); w0 *= iw; w1 *= iw; w2 *= iw;
            const u32x4 a = *(const u32x4*)(OP0 + (size_t)tok * 768 + ch * 8), b = *(const u32x4*)(OP1 + (size_t)tok * 768 + ch * 8), c2 = *(const u32x4*)(OP2 + (size_t)tok * 768 + ch * 8);
            bf16_t* yp = H + (size_t)tok * LDH1 + O_G + 1024 + ch * 8; const u32x4 g = *(const u32x4*)yp; u32x4 w;
#define MIX(aa, bb, cc_, gg) cvt_pk_bf16((w0 * __uint_as_float((aa) << 16) + w1 * __uint_as_float((bb) << 16) + w2 * __uint_as_float((cc_) << 16)) * fa::silu(__uint_as_float((gg) << 16)), \
                (w0 * __uint_as_float((aa) & 0xffff0000u) + w1 * __uint_as_float((bb) & 0xffff0000u) + w2 * __uint_as_float((cc_) & 0xffff0000u)) * fa::silu(__uint_as_float((gg) & 0xffff0000u)))
            w.x = MIX(a.x, b.x, c2.x, g.x); w.y = MIX(a.y, b.y, c2.y, g.y); w.z = MIX(a.z, b.z, c2.z, g.z); w.w = MIX(a.w, b.w, c2.w, g.w);
#undef MIX
            *(u32x4*)yp = w;
        }
    }
    SEAM(7);
    if (IN(8)) {
        if (G == 256 && WGM_OUT == 4) { EpiFinal E{XB, KA()->out, DM, SSQ2, (unsigned*)(ws + WS_CTL) + 8192, KA()->in[17]}; run_gemm(lds, H + O_G, LDH1, WOO, T, DM, 2304, E, 0, wave_s, WGM_OUT); }
        else { EpiRes<true, false> E{XB, nullptr, XB, DM, SSQ2}; run_gemm(lds, H + O_G, LDH1, WOO, T, DM, 2304, E, 0, wave_s, WGM_OUT); }
    }
    if (!(G == 256 && WGM_OUT == 4)) SEAM(8);
    if (IN(9) && !(G == 256 && WGM_OUT == 4)) {
        PHASE_IDS
        const f32x4* gp = (const f32x4*)KA()->in[17] + 2 * lane;
        for (int m = gw; m < T; m += NGW) {
            const float r = 1.0f / sqrtf(SSQ2[m] * (1.0f / DM) + EPS);
            const u32x4* xr = (const u32x4*)(XB + (size_t)m * DM) + lane; f32x4* orow = (f32x4*)(KA()->out + (size_t)m * DM) + 2 * lane;
            u32x4 w[4];
#pragma unroll
            for (int j = 0; j < 4; ++j) w[j] = xr[64 * j];
#pragma unroll
            for (int j = 0; j < 4; ++j) { const f32x4 g0 = gp[128 * j], g1 = gp[128 * j + 1];
                f32x4 v0 = {__uint_as_float(w[j].x << 16), __uint_as_float(w[j].x & 0xffff0000u), __uint_as_float(w[j].y << 16), __uint_as_float(w[j].y & 0xffff0000u)};
                f32x4 v1 = {__uint_as_float(w[j].z << 16), __uint_as_float(w[j].z & 0xffff0000u), __uint_as_float(w[j].w << 16), __uint_as_float(w[j].w & 0xffff0000u)};
                v0 = v0 * r; v0 = v0 * g0; v1 = v1 * r; v1 = v1 * g1; orow[128 * j] = v0; orow[128 * j + 1] = v1; }
        }
    }
#undef KA
#undef PHASE_IDS
#undef IN
#undef SEAM
#undef W1E
#undef WUQ
#undef WUKV
#undef WMKE
#undef WOE
#undef W1O
#undef WMKO
#undef WOO
#undef XB
#undef QA
#undef KVA
#undef H
#undef MEMB
#undef MKVE
#undef MKVO
#undef CS64
#undef CS32
#undef CS16
#undef RS0
#undef SSQQ
#undef SSQKV
#undef SSQ1
#undef SSQ2
#undef RSMEM
#undef KMEAN
}

extern "C" void kernel_launch(void* const* d_in, const int* in_sizes, int n_in, void* d_out, int out_size, void* d_ws, size_t ws_size, hipStream_t stream) {
    static int grid = 0;
    if (grid == 0) {
        if (n_in != 18 || out_size != T * DM || ws_size < WS_END) { fprintf(stderr, "kernel_launch: unexpected shapes (n_in %d out %d ws %zu)\n", n_in, out_size, ws_size); grid = -1; return; }
        int dev = 0, cus = 0, per_cu = 0;
        (void)hipGetDevice(&dev); (void)hipDeviceGetAttribute(&cus, hipDeviceAttributeMultiprocessorCount, dev);
        if (hipFuncSetAttribute((const void*)mega, hipFuncAttributeMaxDynamicSharedMemorySize, LDS_BYTES) != hipSuccess) { fprintf(stderr, "kernel_launch: hipFuncSetAttribute failed\n"); grid = -1; return; }
        (void)hipOccupancyMaxActiveBlocksPerMultiprocessor(&per_cu, (const void*)mega, 512, LDS_BYTES);
        if (per_cu < 1) { fprintf(stderr, "kernel_launch: occupancy query says %d\n", per_cu); per_cu = 1; }
        grid = (cus > 0 ? cus : 256) * 1;
        (void)hipGetLastError();
    }
    if (grid < 0) return;
    (void)hipMemsetAsync((unsigned char*)d_ws + WS_CTL, 0, 65536, stream);
    Args a{};
    for (int i = 0; i < 18; ++i) a.in[i] = (const float*)d_in[i];
    a.out = (float*)d_out; a.ws = (unsigned char*)d_ws;
    a.ph_lo = 0; a.ph_hi = 10;
    void* kargs[] = {&a};
    hipError_t e = hipLaunchCooperativeKernel((const void*)mega, dim3(grid), dim3(512), kargs, LDS_BYTES, stream);
    if (e != hipSuccess) fprintf(stderr, "kernel_launch: cooperative launch failed: %s (grid %d)\n", hipGetErrorString(e), grid);

}
```

```cpp
#include <hip/hip_runtime.h>
#include <hip/hip_cooperative_groups.h>
#include <cstdio>
#include <cstdint>
namespace cg = cooperative_groups;

#ifndef WGM_OUT
#define WGM_OUT 4
#endif
typedef unsigned short bf16_t;
typedef short bf16x8 __attribute__((ext_vector_type(8)));
typedef float f32x4 __attribute__((ext_vector_type(4)));
typedef float f32x2 __attribute__((ext_vector_type(2)));
typedef unsigned u32x4 __attribute__((ext_vector_type(4)));
typedef unsigned u32x2 __attribute__((ext_vector_type(2)));
#define LAS __attribute__((address_space(3)))

constexpr int NB = 4, SEQ = 4096, DM = 2048, T = NB * SEQ, NMEM = 256;
constexpr int LDH0 = 7168, LDH1 = 6400;
constexpr float EPS = 1e-6f;
constexpr int E_CQ = 0, E_CKV = 512, E_KPE = 768, E_QB = 1024, E_KB = 2048, E_VB = 3072, E_QM = 4096, E_G = 4608;
constexpr int O_QC = 0, O_KC = 1024, O_VC = 1152, O_QD = 1280, O_KD = 2048, O_VD = 2816, O_QM = 3584, O_G = 4096;

constexpr size_t MiB = 1u << 20;
constexpr size_t WS_W1E = 0, WS_WUQ = 28 * MiB, WS_WUKV = 30 * MiB, WS_WMKE = 31 * MiB, WS_WOE = 35 * MiB, WS_W1O = 45 * MiB,
                 WS_WMKO = 70 * MiB, WS_WOO = 74 * MiB;
constexpr size_t WS_R1 = 96 * MiB;
constexpr size_t WS_KVA = WS_R1 + 64 * MiB;
constexpr size_t WS_H = 224 * MiB;
constexpr size_t WS_MISC = 448 * MiB;
constexpr size_t WS_MEMB = WS_MISC, WS_MKVE = WS_MISC + 4 * MiB, WS_MKVO = WS_MISC + 6 * MiB;
constexpr size_t WS_CS64 = WS_MISC + 8 * MiB, WS_CS32 = WS_MISC + 9 * MiB, WS_CS16 = WS_MISC + 9 * MiB + 512 * 1024;
constexpr size_t WS_RS0 = WS_MISC + 10 * MiB, WS_SSQQ = WS_RS0 + 65536, WS_SSQKV = WS_RS0 + 2 * 65536, WS_SSQ1 = WS_RS0 + 3 * 65536,
                 WS_SSQ2 = WS_RS0 + 4 * 65536, WS_RSMEM = WS_RS0 + 5 * 65536;
constexpr size_t WS_KMEAN = WS_MISC + 11 * MiB;
constexpr size_t WS_LSE = WS_MISC + 12 * MiB;
constexpr size_t WS_CTL = WS_MISC + 14 * MiB;
constexpr size_t WS_KD = 424 * MiB, WS_VD = 464 * MiB;
constexpr size_t WS_KC = 488 * MiB, WS_VC = 492 * MiB;
constexpr size_t WS_END = 496 * MiB;
__host__ __device__ constexpr size_t ws_op(int p) { return p == 0 ? (size_t)0 : WS_R1 + (size_t)(64 + 24 * (p - 1)) * MiB; }

struct Args { const float* in[18]; float* out; unsigned char* ws; int ph_lo, ph_hi; };

__device__ __forceinline__ int lane_id() { int r = (int)__builtin_amdgcn_mbcnt_hi(~0u, __builtin_amdgcn_mbcnt_lo(~0u, 0u)); asm volatile("" : "+v"(r)); return r; }
template <int MASK> __device__ __forceinline__ float swz_xor(float v) { return __uint_as_float((unsigned)__builtin_amdgcn_ds_swizzle((int)__float_as_uint(v), (MASK << 10) | 0x1F)); }
__device__ __forceinline__ float sum_x32(float v) { auto rr = __builtin_amdgcn_permlane32_swap(__float_as_uint(v), __float_as_uint(v), false, false); return __uint_as_float(rr[0]) + __uint_as_float(rr[1]); }
__device__ __forceinline__ float max_x32(float v) { auto rr = __builtin_amdgcn_permlane32_swap(__float_as_uint(v), __float_as_uint(v), false, false); return fmaxf(__uint_as_float(rr[0]), __uint_as_float(rr[1])); }
__device__ __forceinline__ float xchg_x32(float v) { auto rr = __builtin_amdgcn_permlane32_swap(__float_as_uint(v), __float_as_uint(v), false, false); return __uint_as_float(rr[0] ^ rr[1] ^ __float_as_uint(v)); }
__device__ __forceinline__ float bf2f(bf16_t b) { return __uint_as_float((unsigned)b << 16); }
typedef __bf16 bf16x2_t __attribute__((ext_vector_type(2)));
__device__ __forceinline__ unsigned cvt_pk_bf16(float lo, float hi) { const f32x2 v = {lo, hi}; return __builtin_bit_cast(unsigned, __builtin_convertvector(v, bf16x2_t)); }
__device__ __forceinline__ float wave_sum(float v) {
    v += swz_xor<1>(v); v += swz_xor<2>(v); v += swz_xor<4>(v); v += swz_xor<8>(v); v += swz_xor<16>(v); return sum_x32(v);
}
__device__ __forceinline__ float wave_max(float v) {
    v = fmaxf(v, swz_xor<1>(v)); v = fmaxf(v, swz_xor<2>(v)); v = fmaxf(v, swz_xor<4>(v)); v = fmaxf(v, swz_xor<8>(v)); v = fmaxf(v, swz_xor<16>(v)); return max_x32(v);
}

__device__ __forceinline__ void blockmap(int mat, int db, int& src, int& half) {
    src = 64 * db; half = 0;
    if (mat == 0) {
        if (db < 12) return;
        if (db == 12) { half = 32; return; }
        if (db < 16) { src = -1; return; }
        if (db < 64) { const int j = 64 * db - 1024; src = 832 + j; if ((j >> 10) < 2 && (j & 127) == 0) half = 16; return; }
        if (db < 72) { src = 3904 + (64 * db - 4096); return; }
        src = 4416 + (64 * db - 4608); return;
    }
    if (mat == 1) { if (db % 3 == 2) half = 32; return; }
    if (mat == 5) { if (db < 18) half = 8; else if (db >= 20 && db < 56) { const int j = 64 * db - 1280; if (j / 768 < 2 && (j & 127) == 0) half = 16; } return; }
}
__device__ __forceinline__ void transpose_item(const float* W, int K, int Nsrc, bf16_t* WT, const float* g, int mat, LAS float* scr, int item, int nblk, int lane) {
    const int kb = item / nblk, db = item - kb * nblk, k0 = 64 * kb, n0 = 64 * db;
    int src, half; blockmap(mat, db, src, half);
    const int s4 = 4 * (lane & 15), kr = lane >> 4;
    f32x4 v[16];
    if (src >= 0) {
#pragma unroll
        for (int i = 0; i < 16; ++i) v[i] = __builtin_nontemporal_load((const f32x4*)(W + (size_t)(k0 + kr + 4 * i) * Nsrc + src + s4));
        if (g) {
#pragma unroll
            for (int i = 0; i < 16; ++i) v[i] = v[i] * g[k0 + kr + 4 * i];
        }
    } else {
#pragma unroll
        for (int i = 0; i < 16; ++i) v[i] = (f32x4){0.f, 0.f, 0.f, 0.f};
    }
    int dr[4];
#pragma unroll
    for (int e = 0; e < 4; ++e) { const int sc_ = s4 + e; dr[e] = sc_ < 2 * half ? (sc_ < half ? 2 * sc_ : 2 * (sc_ - half) + 1) : sc_; }
#pragma unroll
    for (int i = 0; i < 16; ++i) { LAS float* rowp = scr + (kr + 4 * i) * 65; rowp[dr[0]] = v[i].x; rowp[dr[1]] = v[i].y; rowp[dr[2]] = v[i].z; rowp[dr[3]] = v[i].w; }
    asm volatile("s_waitcnt lgkmcnt(0)" ::: "memory");
    const int c = lane & 7;
#pragma unroll
    for (int j = 0; j < 8; ++j) { const int n = (lane >> 3) + 8 * j; const LAS float* sp = scr + (8 * c) * 65 + n;
        u32x4 o; o.x = cvt_pk_bf16(sp[0 * 65], sp[1 * 65]); o.y = cvt_pk_bf16(sp[2 * 65], sp[3 * 65]); o.z = cvt_pk_bf16(sp[4 * 65], sp[5 * 65]); o.w = cvt_pk_bf16(sp[6 * 65], sp[7 * 65]);
        *(u32x4*)(WT + (size_t)(n0 + n) * K + k0 + 8 * c) = o; }
    asm volatile("s_waitcnt lgkmcnt(0)" ::: "memory");
}

__device__ __forceinline__ void row_to_bf16(const float* xrow, bf16_t* orow, float* rs, int lane) {
    const f32x4* xr = (const f32x4*)xrow + lane; f32x4 v[8]; float s = 0.f;
#pragma unroll
    for (int j = 0; j < 8; ++j) { v[j] = __builtin_nontemporal_load(xr + 64 * j); s += (v[j].x * v[j].x + v[j].y * v[j].y) + (v[j].z * v[j].z + v[j].w * v[j].w); }
    s = wave_sum(s);
    if (lane == 0) *rs = 1.0f / sqrtf(s * (1.0f / DM) + EPS);
    u32x2* o8 = (u32x2*)orow + lane;
#pragma unroll
    for (int j = 0; j < 8; ++j) { u32x2 w; w.x = cvt_pk_bf16(v[j].x, v[j].y); w.y = cvt_pk_bf16(v[j].z, v[j].w); o8[64 * j] = w; }
}

namespace pg8 {
constexpr int BM = 256, BK = 64, HALF = 128, HTB = HALF * BK * 2, STAGE_BYTES = 8 * HTB, NXCD = 8;
__host__ __device__ __forceinline__ int lds_byte(int r, int c) { const int st = (r >> 4) * 2 + (c >> 5), rr = r & 15, cc = c & 31, ob = rr * 64 + cc * 2; return st * 1024 + (ob ^ (((ob >> 9) & 1) << 5)); }
__host__ __device__ __forceinline__ void stage_rc(int b, int& R, int& C) { const int st = b / 1024, sb = b % 1024, swz = sb ^ (((sb >> 9) & 1) << 5); R = (st >> 1) * 16 + swz / 64; C = (st & 1) * 32 + (swz % 64) / 2; }
__host__ __device__ __forceinline__ int perm32(int rho) { const int n = rho >> 4, i = rho & 15; return 8 * (i >> 2) + 4 * n + (i & 3); }
struct Unit { int pm, pn; };
struct Gemm { const bf16_t* A; const bf16_t* Bt; int M, N, K, lda; };
struct StaticOrder {
    int nM, nN, nwg, G, c, WGM;
    __host__ __device__ void init(int M, int N, int G_, int c_, int wgm_ = 2) { nM = M / BM; nN = N / BM; nwg = nM * nN; G = G_; c = c_; WGM = wgm_; }
    __host__ __device__ void unit_of(int L, Unit& u) const {
        int wgid = L; { const int q = nwg / NXCD, r = nwg % NXCD, xcd = wgid % NXCD, off = wgid / NXCD; wgid = (xcd < r ? xcd * (q + 1) : r * (q + 1) + (xcd - r) * q) + off; }
        const int nig = WGM * nN, gid = wgid / nig, fm = gid * WGM, gsz = (nM - fm) < WGM ? (nM - fm) : WGM;
        u.pm = fm + ((wgid % nig) % gsz); u.pn = (wgid % nig) / gsz;
    }
    __host__ __device__ bool next(int i, Unit& u) const {
        if (c < 0) return false;
        const long L = (long)i * G + c; if (L >= nwg) return false;
        unit_of((int)L, u); return true;
    }
};

template <class Epi, class Sched>
__device__ __forceinline__ void gemm_phase(LAS unsigned char* lds, const Gemm g, const Sched& S, const Epi& E, const int wid) {
    const int lane = lane_id(), tid = wid * 64 + lane, wr = wid >> 2, wc = wid & 3, fr = lane & 15, fq = lane >> 4;
    const int K = g.K, nt = K / BK;
    unsigned voffA[2], voffB[2];
#pragma unroll
    for (int i = 0; i < 2; ++i) { int R, C; stage_rc(tid * 16 + i * 8192, R, C); const int Rb = (R & ~31) + perm32(R & 31); voffA[i] = (unsigned)(R * g.lda + C) * 2u; voffB[i] = (unsigned)(Rb * K + C) * 2u; }
    const size_t kstep = (size_t)(BK * 2);
    const size_t hstepA = (size_t)HALF * g.lda * 2, hstepB = (size_t)HALF * K * 2, tstepA = 2 * hstepA, tstepB = 2 * hstepB;
    const unsigned ldsw = (unsigned)wid * 1024u;
    const int aoff = lds_byte(wr * 64 + fr, fq * 8), boff = lds_byte(wc * 32 + fr, fq * 8);
#define PG8_SA(b, h) (((b) * 2 + (h)) * HTB)
#define PG8_SB(b, h) ((4 + (b) * 2 + (h)) * HTB)
#define PG8_STAGE(bufoff, gbase, voff) do { _Pragma("unroll") for (int _i = 0; _i < 2; ++_i) \
        __builtin_amdgcn_global_load_lds((const unsigned*)((const char*)(gbase) + (voff)[_i]), (LAS unsigned*)(lds + (bufoff) + ldsw + _i * 8192), 16, 0, 0); } while (0)
#define PG8_LDA(dst, b, h) do { _Pragma("unroll") for (int m = 0; m < 4; ++m) _Pragma("unroll") for (int k = 0; k < 2; ++k) dst[m][k] = *(const LAS bf16x8*)(lds + PG8_SA(b, h) + aoff + m * 2048 + k * 1024); } while (0)
#define PG8_LDB(dst, b, h) do { _Pragma("unroll") for (int n = 0; n < 2; ++n) _Pragma("unroll") for (int k = 0; k < 2; ++k) dst[n][k] = *(const LAS bf16x8*)(lds + PG8_SB(b, h) + boff + n * 2048 + k * 1024); } while (0)
#define PG8_MMA(ai, bj, At, Bt) do { __builtin_amdgcn_s_setprio(1); _Pragma("unroll") for (int m = 0; m < 4; ++m) _Pragma("unroll") for (int n = 0; n < 2; ++n) _Pragma("unroll") for (int k = 0; k < 2; ++k) \
        acc[ai][bj][m][n] = __builtin_amdgcn_mfma_f32_16x16x32_bf16(Bt[n][k], At[m][k], acc[ai][bj][m][n], 0, 0, 0); __builtin_amdgcn_s_setprio(0); } while (0)
#define PG8_WAIT_V(n) asm volatile("s_waitcnt vmcnt(" #n ")" ::: "memory")
#define PG8_WAIT_L(n) asm volatile("s_waitcnt lgkmcnt(" #n ")" ::: "memory")
#define PG8_BAR __builtin_amdgcn_s_barrier()
#define PG8_SCHED __builtin_amdgcn_sched_barrier(0)
    Unit cur, nxt; int ui = 0;
    if (!S.next(0, cur)) return;
    f32x4 acc[2][2][4][2];
#pragma unroll
    for (int a = 0; a < 2; ++a)
#pragma unroll
        for (int b = 0; b < 2; ++b)
#pragma unroll
            for (int m = 0; m < 4; ++m)
#pragma unroll
                for (int n = 0; n < 2; ++n) acc[a][b][m][n] = (f32x4){0.f, 0.f, 0.f, 0.f};
    bf16x8 At[4][2], B0[2][2], B1[2][2];
    const char* cA = (const char*)g.A + (size_t)cur.pm * tstepA; const char* cB = (const char*)g.Bt + (size_t)cur.pn * tstepB;
    PG8_STAGE(PG8_SB(0, 0), cB, voffB); PG8_STAGE(PG8_SB(0, 1), cB + hstepB, voffB); PG8_STAGE(PG8_SA(0, 0), cA, voffA); PG8_STAGE(PG8_SA(0, 1), cA + hstepA, voffA);
    if (wr == 1) PG8_BAR;
    PG8_WAIT_V(2); PG8_BAR;
    PG8_STAGE(PG8_SB(1, 0), cB + kstep, voffB); PG8_STAGE(PG8_SA(1, 0), cA + kstep, voffA); PG8_STAGE(PG8_SB(1, 1), cB + hstepB + kstep, voffB);
    PG8_WAIT_V(6); PG8_BAR;
    for (;;) {
        const bool has_next = S.next(ui + 1, nxt);
        const char* nA = has_next ? (const char*)g.A + (size_t)nxt.pm * tstepA : cA; const char* nB = has_next ? (const char*)g.Bt + (size_t)nxt.pn * tstepB : cB;
#pragma unroll 1
        for (int t = 0; t < nt; t += 2) {
            const bool last = (t == nt - 2);
            const char* a1 = cA + (size_t)(t + 1) * kstep;
            const char* a2 = last ? nA : cA + (size_t)(t + 2) * kstep; const char* b2 = last ? nB : cB + (size_t)(t + 2) * kstep;
            const char* a3 = a2 + kstep; const char* b3 = b2 + kstep;
            PG8_LDB(B0, 0, 0); PG8_LDB(B1, 0, 1); PG8_SCHED; PG8_LDA(At, 0, 0); PG8_STAGE(PG8_SA(1, 1), a1 + hstepA, voffA);
            PG8_WAIT_V(8); PG8_WAIT_L(0); PG8_BAR; PG8_MMA(0, 0, At, B0); PG8_MMA(0, 1, At, B1); PG8_BAR; PG8_SCHED;
            PG8_LDA(At, 0, 1); PG8_STAGE(PG8_SB(0, 0), b2, voffB); PG8_STAGE(PG8_SB(0, 1), b2 + hstepB, voffB); PG8_STAGE(PG8_SA(0, 0), a2, voffA);
            PG8_WAIT_V(8); PG8_WAIT_L(0); PG8_BAR; PG8_MMA(1, 0, At, B0); PG8_MMA(1, 1, At, B1); PG8_BAR; PG8_SCHED;
            PG8_LDB(B0, 1, 0); PG8_LDB(B1, 1, 1); PG8_SCHED; PG8_LDA(At, 1, 0); PG8_STAGE(PG8_SA(0, 1), a2 + hstepA, voffA);
            PG8_WAIT_V(8); PG8_WAIT_L(0); PG8_BAR; PG8_MMA(0, 0, At, B0); PG8_MMA(0, 1, At, B1); PG8_BAR; PG8_SCHED;
            PG8_LDA(At, 1, 1); PG8_STAGE(PG8_SB(1, 0), b3, voffB); PG8_STAGE(PG8_SB(1, 1), b3 + hstepB, voffB); PG8_STAGE(PG8_SA(1, 0), a3, voffA);
            PG8_WAIT_V(8); PG8_WAIT_L(0); PG8_BAR; PG8_MMA(1, 0, At, B0); PG8_MMA(1, 1, At, B1); PG8_BAR; PG8_SCHED;
        }
        if (wr == 0) PG8_BAR;
        E(acc, cur, wr, wc, fr, fq);
        if (!has_next) break;
#pragma unroll
        for (int a = 0; a < 2; ++a)
#pragma unroll
            for (int b = 0; b < 2; ++b)
#pragma unroll
                for (int m = 0; m < 4; ++m)
#pragma unroll
                    for (int n = 0; n < 2; ++n) acc[a][b][m][n] = (f32x4){0.f, 0.f, 0.f, 0.f};
        cur = nxt; cA = nA; cB = nB; ++ui;
        if (wr == 1) PG8_BAR;
    }
    PG8_WAIT_V(0);
    PG8_BAR;
#undef PG8_SA
#undef PG8_SB
#undef PG8_STAGE
#undef PG8_LDA
#undef PG8_LDB
#undef PG8_MMA
#undef PG8_WAIT_V
#undef PG8_WAIT_L
#undef PG8_BAR
#undef PG8_SCHED
}
}

template <int MODE> struct EpiBF {
    bf16_t* O; int ldc; const float* rs; const float* ssq_in; float inv_n; float* ssq_a; float* ssq_b;
    const f32x2* cs64; const f32x2* cs32; const f32x2* cs16;
    __device__ __forceinline__ void operator()(const f32x4 (&acc)[2][2][4][2], const pg8::Unit& u, int wr, int wc, int fr, int fq) const {
        asm volatile("" : "+v"(fr), "+v"(fq));
        const int row0 = u.pm * 256 + wr * 64 + fr;
        float sc[2][4];
#pragma unroll
        for (int ai = 0; ai < 2; ++ai)
#pragma unroll
            for (int m = 0; m < 4; ++m) sc[ai][m] = (MODE == 1 || MODE == 2 || MODE == 3) ? ssq_in[row0 + ai * 128 + m * 16] : rs[row0 + ai * 128 + m * 16];
        if (MODE == 1 || MODE == 2 || MODE == 3) {
#pragma unroll
            for (int ai = 0; ai < 2; ++ai)
#pragma unroll
                for (int m = 0; m < 4; ++m) sc[ai][m] = 1.0f / sqrtf(sc[ai][m] * inv_n + EPS);
        }
        float ss[2][4] = {{0.f, 0.f, 0.f, 0.f}, {0.f, 0.f, 0.f, 0.f}};
        const bool do_ss = (MODE == 0) && u.pn < 3 && ssq_a != nullptr;
        const bool gate_tile = (MODE == 0 && u.pn >= 18) || (MODE == 3 && u.pn >= 16);
#pragma unroll
        for (int bj = 0; bj < 2; ++bj) {
            const int colb = u.pn * 256 + bj * 128 + wc * 32, col = colb + 8 * fq;
            bf16_t* dst = O; int dld = ldc, dcol = col;
            if (MODE == 3) {
                unsigned char* wsb = (unsigned char*)O - WS_H;
                if (u.pn == 4) { dst = (bf16_t*)(wsb + (bj == 0 ? WS_KC : WS_VC)) + (size_t)(wc >> 1) * T * 64; dld = 64; dcol = (wc & 1) * 32 + 8 * fq; }
                else if (u.pn >= 8 && u.pn < 14) { const int hd = u.pn * 2 + bj - (u.pn < 11 ? 16 : 22); dst = (bf16_t*)(wsb + (u.pn < 11 ? WS_KD : WS_VD)) + (size_t)hd * T * 128; dld = 128; dcol = wc * 32 + 8 * fq; }
            }
            const f32x2* tb = nullptr; int nf = 0, i0 = 4 * fq; bool lrope = true;
            if (MODE == 0) {
                if (u.pn == 3 && bj == 0 && wc < 2) { tb = cs64; nf = 32; i0 = wc * 16 + 4 * fq; }
                else if (u.pn >= 4 && u.pn < 12 && wc == 0) { tb = cs32; nf = 16; }
            } else if (MODE == 1) {
                const int d = colb % 192; if (d >= 128) { tb = cs64; nf = 32; i0 = ((d - 128) >> 1) + 4 * fq; }
            } else if (MODE == 3) {
                if ((u.pn < 4 || (u.pn == 4 && bj == 0)) && (wc & 1) == 0) { tb = cs16; nf = 8; lrope = fq < 2; if (!lrope) i0 = 0; }
                else if (u.pn >= 5 && u.pn < 11 && wc == 0) { tb = cs32; nf = 16; }
            }
            if (tb != nullptr) {
#pragma unroll
                for (int h4 = 0; h4 < 4; ++h4) {
                    const int ai = h4 >> 1, mb = (h4 & 1) * 2;
                    f32x4 t0[2], t1[2];
#pragma unroll
                    for (int mm = 0; mm < 2; ++mm) { const int pos = (row0 + ai * 128 + (mb + mm) * 16) & (SEQ - 1); const f32x4* tp = (const f32x4*)(tb + pos * nf + i0); t0[mm] = tp[0]; t1[mm] = tp[1]; }
#pragma unroll
                    for (int mm = 0; mm < 2; ++mm) { const int m = mb + mm;
                        const f32x4 v0 = acc[ai][bj][m][0] * sc[ai][m], v1 = acc[ai][bj][m][1] * sc[ai][m]; const f32x4 a = t0[mm], b = t1[mm];
                        f32x4 r0, r1;
                        r0.x = v0.x * a.x - v0.y * a.y; r0.y = v0.x * a.y + v0.y * a.x; r0.z = v0.z * a.z - v0.w * a.w; r0.w = v0.z * a.w + v0.w * a.z;
                        r1.x = v1.x * b.x - v1.y * b.y; r1.y = v1.x * b.y + v1.y * b.x; r1.z = v1.z * b.z - v1.w * b.w; r1.w = v1.z * b.w + v1.w * b.z;
                        if (!lrope) { r0 = v0; r1 = v1; }
                        u32x4 w; w.x = cvt_pk_bf16(r0.x, r0.y); w.y = cvt_pk_bf16(r0.z, r0.w); w.z = cvt_pk_bf16(r1.x, r1.y); w.w = cvt_pk_bf16(r1.z, r1.w);
                        *(u32x4*)(dst + (size_t)(row0 + ai * 128 + m * 16) * dld + dcol) = w;
                    }
                }
            } else {
#pragma unroll
                for (int ai = 0; ai < 2; ++ai)
#pragma unroll
                    for (int m = 0; m < 4; ++m) {
                        const f32x4 v0 = acc[ai][bj][m][0] * sc[ai][m], v1 = acc[ai][bj][m][1] * sc[ai][m];
                        if (MODE == 0) ss[ai][m] += ((v0.x * v0.x + v0.y * v0.y) + (v0.z * v0.z + v0.w * v0.w)) + ((v1.x * v1.x + v1.y * v1.y) + (v1.z * v1.z + v1.w * v1.w));
                        u32x4 w; w.x = cvt_pk_bf16(v0.x, v0.y); w.y = cvt_pk_bf16(v0.z, v0.w); w.z = cvt_pk_bf16(v1.x, v1.y); w.w = cvt_pk_bf16(v1.z, v1.w);
                        if (gate_tile) __builtin_nontemporal_store(w, (u32x4*)(dst + (size_t)(row0 + ai * 128 + m * 16) * dld + dcol));
                        else *(u32x4*)(dst + (size_t)(row0 + ai * 128 + m * 16) * dld + dcol) = w;
                    }
            }
        }
        if (do_ss) {
            float* dst = u.pn < 2 ? ssq_a : ssq_b;
#pragma unroll
            for (int ai = 0; ai < 2; ++ai)
#pragma unroll
                for (int m = 0; m < 4; ++m) { float t = ss[ai][m]; t += swz_xor<16>(t); t = sum_x32(t); if (fq == 0) atomicAdd(dst + row0 + ai * 128 + m * 16, t); }
        }
    }
};
template <bool BB, bool WF> struct EpiRes {
    const void* base; float* out; bf16_t* ob; int ldc; float* ssq;
    __device__ __forceinline__ void operator()(const f32x4 (&acc)[2][2][4][2], const pg8::Unit& u, int wr, int wc, int fr, int fq) const {
        asm volatile("" : "+v"(fr), "+v"(fq));
        const int row0 = u.pm * 256 + wr * 64 + fr, col0 = u.pn * 256 + wc * 32 + 8 * fq;
#pragma unroll
        for (int h2 = 0; h2 < 4; ++h2) {
            const int ai = h2 >> 1, mb = (h2 & 1) * 2;
            f32x4 pre[2][2][2];
#pragma unroll
            for (int mm = 0; mm < 2; ++mm)
#pragma unroll
                for (int bj = 0; bj < 2; ++bj) {
                    const size_t off = (size_t)(row0 + ai * 128 + (mb + mm) * 16) * ldc + col0 + bj * 128;
                    if (BB) { const u32x4 w = *(const u32x4*)((const bf16_t*)base + off);
                        pre[mm][bj][0] = (f32x4){__uint_as_float(w.x << 16), __uint_as_float(w.x & 0xffff0000u), __uint_as_float(w.y << 16), __uint_as_float(w.y & 0xffff0000u)};
                        pre[mm][bj][1] = (f32x4){__uint_as_float(w.z << 16), __uint_as_float(w.z & 0xffff0000u), __uint_as_float(w.w << 16), __uint_as_float(w.w & 0xffff0000u)}; }
                    else { const float* p = (const float*)base + off; pre[mm][bj][0] = *(const f32x4*)p; pre[mm][bj][1] = *(const f32x4*)(p + 4); } }
#pragma unroll
            for (int mm = 0; mm < 2; ++mm) {
                const int m = mb + mm, row = row0 + ai * 128 + m * 16; float ss = 0.f;
#pragma unroll
                for (int bj = 0; bj < 2; ++bj) {
                    const size_t off = (size_t)row * ldc + col0 + bj * 128;
                    const f32x4 o0 = pre[mm][bj][0] + acc[ai][bj][m][0], o1 = pre[mm][bj][1] + acc[ai][bj][m][1];
                    if (WF) { *(f32x4*)(out + off) = o0; *(f32x4*)(out + off + 4) = o1; }
                    ss += ((o0.x * o0.x + o0.y * o0.y) + (o0.z * o0.z + o0.w * o0.w)) + ((o1.x * o1.x + o1.y * o1.y) + (o1.z * o1.z + o1.w * o1.w));
                    if (ob) { u32x4 w; w.x = cvt_pk_bf16(o0.x, o0.y); w.y = cvt_pk_bf16(o0.z, o0.w); w.z = cvt_pk_bf16(o1.x, o1.y); w.w = cvt_pk_bf16(o1.z, o1.w); *(u32x4*)(ob + off) = w; }
                }
                if (ssq) { ss += swz_xor<16>(ss); ss = sum_x32(ss); if (fq == 0) atomicAdd(ssq + row, ss); }
            }
        }
    }
};

struct EpiFinal {
    const bf16_t* base; float* out; int ldc; float* ssq; unsigned* cnt; const float* g;
    __device__ __forceinline__ void operator()(f32x4 (&acc)[2][2][4][2], const pg8::Unit& u, int wr, int wc, int fr, int fq) const {
        asm volatile("" : "+v"(fr), "+v"(fq));
        const int row0 = u.pm * 256 + wr * 64 + fr, col0 = u.pn * 256 + wc * 32 + 8 * fq;
#pragma unroll
        for (int h2 = 0; h2 < 4; ++h2) {
            const int ai = h2 >> 1, mb = (h2 & 1) * 2;
            u32x4 pre[2][2];
#pragma unroll
            for (int mm = 0; mm < 2; ++mm)
#pragma unroll
                for (int bj = 0; bj < 2; ++bj) pre[mm][bj] = *(const u32x4*)(base + (size_t)(row0 + ai * 128 + (mb + mm) * 16) * ldc + col0 + bj * 128);
#pragma unroll
            for (int mm = 0; mm < 2; ++mm) {
                const int m = mb + mm, row = row0 + ai * 128 + m * 16; float ss = 0.f;
#pragma unroll
                for (int bj = 0; bj < 2; ++bj) {
                    const u32x4 w = pre[mm][bj];
                    const f32x4 o0 = (f32x4){__uint_as_float(w.x << 16), __uint_as_float(w.x & 0xffff0000u), __uint_as_float(w.y << 16), __uint_as_float(w.y & 0xffff0000u)} + acc[ai][bj][m][0];
                    const f32x4 o1 = (f32x4){__uint_as_float(w.z << 16), __uint_as_float(w.z & 0xffff0000u), __uint_as_float(w.w << 16), __uint_as_float(w.w & 0xffff0000u)} + acc[ai][bj][m][1];
                    acc[ai][bj][m][0] = o0; acc[ai][bj][m][1] = o1;
                    ss += ((o0.x * o0.x + o0.y * o0.y) + (o0.z * o0.z + o0.w * o0.w)) + ((o1.x * o1.x + o1.y * o1.y) + (o1.z * o1.z + o1.w * o1.w));
                }
                ss += swz_xor<16>(ss); ss = sum_x32(ss); if (fq == 0) atomicAdd(ssq + row, ss);
            }
        }
        asm volatile("s_waitcnt vmcnt(0)" ::: "memory");
        __builtin_amdgcn_s_barrier();
        if (wr == 0 && wc == 0) {
            unsigned* cw = cnt + 64 * u.pm;
            if (fr == 0 && fq == 0) __hip_atomic_fetch_add(cw, 1u, __ATOMIC_RELAXED, __HIP_MEMORY_SCOPE_AGENT);
            unsigned sp = 0; while (__hip_atomic_load(cw, __ATOMIC_RELAXED, __HIP_MEMORY_SCOPE_AGENT) < 8u && ++sp < (1u << 22)) __builtin_amdgcn_s_sleep(2);
        }
        __builtin_amdgcn_s_barrier();
        float rsv[2][4];
#pragma unroll
        for (int ai = 0; ai < 2; ++ai)
#pragma unroll
            for (int m = 0; m < 4; ++m) rsv[ai][m] = __hip_atomic_load(ssq + row0 + ai * 128 + m * 16, __ATOMIC_RELAXED, __HIP_MEMORY_SCOPE_AGENT);
#pragma unroll
        for (int ai = 0; ai < 2; ++ai)
#pragma unroll
            for (int m = 0; m < 4; ++m) rsv[ai][m] = 1.0f / sqrtf(rsv[ai][m] * (1.0f / DM) + EPS);
#pragma unroll
        for (int bj = 0; bj < 2; ++bj) {
            const f32x4 g0 = *(const f32x4*)(g + col0 + bj * 128), g1 = *(const f32x4*)(g + col0 + bj * 128 + 4);
#pragma unroll
            for (int ai = 0; ai < 2; ++ai)
#pragma unroll
                for (int m = 0; m < 4; ++m) {
                    const size_t off = (size_t)(row0 + ai * 128 + m * 16) * ldc + col0 + bj * 128; const float r = rsv[ai][m];
                    *(f32x4*)(out + off) = acc[ai][bj][m][0] * r * g0; *(f32x4*)(out + off + 4) = acc[ai][bj][m][1] * r * g1;
                }
        }
    }
};

struct TailUnits { int c, G, n, pn; __device__ __forceinline__ bool next(int i, pg8::Unit& u) const { const int pm = c + i * G; if (pm >= n) return false; u.pm = pm; u.pn = pn; return true; } };
template <class Epi, class Sched>
__device__ __forceinline__ void run_gemm_s(LAS unsigned char* lds, const bf16_t* A, int lda, const bf16_t* Bt, int M, int N, int K, const Epi& E, const Sched& S, const int wave_s) {
    pg8::Gemm g{A, Bt, M, N, K, lda};
    pg8::gemm_phase<Epi, Sched>(lds, g, S, E, wave_s);
}
template <class Epi>
__device__ __forceinline__ void run_gemm(LAS unsigned char* lds, const bf16_t* A, int lda, const bf16_t* Bt, int M, int N, int K, const Epi& E, int coff, const int wave_s, const int wgm = 2) {
    pg8::Gemm g{A, Bt, M, N, K, lda}; pg8::StaticOrder S; int cc_ = (int)blockIdx.x + coff; if (cc_ >= (int)gridDim.x) cc_ -= (int)gridDim.x; S.init(M, N, (int)gridDim.x, cc_, wgm);
    pg8::gemm_phase<Epi, pg8::StaticOrder>(lds, g, S, E, wave_s);
}

namespace fa {
typedef float f32x16 __attribute__((ext_vector_type(16)));
typedef short s16x4 __attribute__((ext_vector_type(4)));
constexpr int KMAXB = 24576, VMAXB = 16384;
constexpr int OFF_V = 3 * KMAXB, OFF_SCR = OFF_V + 2 * VMAXB, OFF_STG = 0, OFF_Q = OFF_SCR + 8 * 256, LDS_NEED = OFF_Q + 16;
constexpr float THR = 8.f;
__device__ __forceinline__ s16x4 vtr(const LAS unsigned char* p) { return __builtin_bit_cast(s16x4, __builtin_amdgcn_ds_read_tr16_b64_v4i16((LAS s16x4*)p)); }
__device__ __forceinline__ float silu(float g) { return g * __builtin_amdgcn_rcpf(1.0f + __builtin_amdgcn_exp2f(-1.4426950408889634f * g)); }

template <int MODE>
__device__ __forceinline__ void attn_item(LAS unsigned char* lds, unsigned char* ws, const float* sinks, int item, const int wave) {
    constexpr int DQK = MODE == 0 ? 192 : MODE == 3 ? 64 : 128, DV = MODE == 3 ? 64 : 128;
    constexpr int NKC = DQK / 64, NVC = DV / 64, ND0 = DQK / 16, NDV = DV / 32;
    constexpr int LDH = (MODE <= 2) ? LDH0 : LDH1;
    constexpr bool CAUSAL = (MODE == 0 || MODE == 1), NOMASK = (MODE == 2 || MODE == 5);
    constexpr unsigned WD = CAUSAL ? 0x7fffffffu : (MODE == 3 ? 127u : 128u);
    constexpr float SCALE = MODE == 0 ? 0.07216878364870322f : MODE == 3 ? 0.125f : 0.08838834764831845f;
    constexpr float C2 = SCALE * 1.4426950408889634f;
    int tid = wave * 64 + lane_id(); asm volatile("" : "+v"(tid));
    const int lane = tid & 63, c = lane & 31, hi = lane >> 5;
    bf16_t* H = (bf16_t*)(ws + WS_H);
    const bf16_t* qrow; const bf16_t* kbase; const bf16_t* k2base = nullptr; const bf16_t* vbase; long kstride, vstride, k2stride = 0;
    int qpos, kt_first, nt, blk = 0; long tok0, tokstep = 1; int ycol = 0, hh, pat = 0;
    if (MODE == 0 || MODE == 1) {
        const int qt = 15 - (item >> 5), bh = item & 31, b = bh >> 3; hh = bh & 7; blk = qt;
        tok0 = (long)b * SEQ + 256 * qt + 32 * wave; qpos = 256 * qt + 32 * wave; kt_first = 0; nt = 4 * (qt + 1);
        if (MODE == 0) {
            qrow = (const bf16_t*)sinks + (tok0 + c) * 1536 + hh * 192;
            kbase = (const bf16_t*)(ws + WS_KVA) + (long)b * SEQ * 2048 + hh * 256; kstride = 2048; vbase = kbase + 128; vstride = 2048;
            k2base = H + (long)b * SEQ * LDH0 + E_KPE; k2stride = LDH0; ycol = E_G + hh * 128;
        } else {
            qrow = H + (tok0 + c) * LDH0 + E_QB + hh * 128; kbase = H + (long)b * SEQ * LDH0 + E_KB + hh * 128; vbase = H + (long)b * SEQ * LDH0 + E_VB + hh * 128;
            kstride = vstride = LDH0; ycol = E_G + 1024 + hh * 128;
        }
    } else if (MODE == 2 || MODE == 5) {
        const int b = item >> 6, qt = item & 15; hh = (item >> 4) & 3;
        tok0 = (long)b * SEQ + 256 * qt + 32 * wave; qpos = 0; kt_first = 0; nt = 4;
        const bf16_t* MKV = (const bf16_t*)(ws + (MODE == 2 ? WS_MKVE : WS_MKVO));
        qrow = H + (tok0 + c) * LDH + (MODE == 2 ? E_QM : O_QM) + hh * 128;
        kbase = MKV + (long)b * NMEM * 1024 + hh * 128; vbase = kbase + 512; kstride = vstride = 1024;
        ycol = (MODE == 2 ? E_G + 2048 : O_G + 1792) + hh * 128;
    } else if (MODE == 3) {
        const int b = item >> 8, kvh = (item >> 7) & 1, tt = item & 127, t0 = 32 * tt; hh = kvh * 8 + wave;
        tok0 = (long)b * SEQ + t0; qpos = t0; kt_first = (t0 > 127 ? t0 - 127 : 0) & ~63; nt = ((t0 + 31) >> 6) - (kt_first >> 6) + 1;
        qrow = H + (tok0 + c) * LDH1 + O_QC + hh * 64; kbase = (const bf16_t*)(ws + WS_KC) + ((long)kvh * T + (long)b * SEQ) * 64; vbase = (const bf16_t*)(ws + WS_VC) + ((long)kvh * T + (long)b * SEQ) * 64;
        kstride = vstride = 64; ycol = O_G + hh * 64;
    } else {
        pat = item / 384; const int jj = item - pat * 384; hh = jj % 6; const int rest = jj / 6, b = rest >> 4;
        int r, qt, d;
        if (pat == 0) { r = 0; qt = rest & 15; d = 1; } else if (pat == 1) { r = (rest >> 2) & 3; qt = rest & 3; d = 4; } else { r = rest & 15; qt = 0; d = 16; }
        const long base = (long)b * SEQ + r; qpos = 256 * qt + 32 * wave; tokstep = d; tok0 = base + (long)d * qpos;
        kt_first = qt > 0 ? 256 * qt - 128 : 0; nt = 4 * (qt + 1) - (kt_first >> 6);
        qrow = H + (tok0 + (long)d * c) * LDH1 + O_QD + hh * 128; kbase = (const bf16_t*)(ws + WS_KD) + ((long)hh * T + base) * 128; vbase = (const bf16_t*)(ws + WS_VD) + ((long)hh * T + base) * 128;
        kstride = vstride = (long)d * 128;
    }
    bf16x8 qf[ND0];
#pragma unroll
    for (int d0 = 0; d0 < ND0; ++d0) qf[d0] = *(const bf16x8*)(qrow + 16 * d0 + 8 * hi);
    unsigned selmask = 0;
    if (MODE == 1 && blk > 0) {
        const float* km = (const float*)(ws + WS_KMEAN) + ((size_t)((item & 31) * 16 + (c & 15))) * 128;
        f32x16 G = {0.f, 0.f, 0.f, 0.f, 0.f, 0.f, 0.f, 0.f, 0.f, 0.f, 0.f, 0.f, 0.f, 0.f, 0.f, 0.f};
#pragma unroll
        for (int d0 = 0; d0 < 8; ++d0) {
            f32x4 a = *(const f32x4*)(km + 16 * d0 + 8 * hi), b = *(const f32x4*)(km + 16 * d0 + 8 * hi + 4);
            if (c >= 16) { a = (f32x4){0.f, 0.f, 0.f, 0.f}; b = a; }
            u32x4 wh; wh.x = cvt_pk_bf16(a.x, a.y); wh.y = cvt_pk_bf16(a.z, a.w); wh.z = cvt_pk_bf16(b.x, b.y); wh.w = cvt_pk_bf16(b.z, b.w);
            f32x4 ra, rb;
            ra.x = a.x - __uint_as_float(wh.x << 16); ra.y = a.y - __uint_as_float(wh.x & 0xffff0000u); ra.z = a.z - __uint_as_float(wh.y << 16); ra.w = a.w - __uint_as_float(wh.y & 0xffff0000u);
            rb.x = b.x - __uint_as_float(wh.z << 16); rb.y = b.y - __uint_as_float(wh.z & 0xffff0000u); rb.z = b.z - __uint_as_float(wh.w << 16); rb.w = b.w - __uint_as_float(wh.w & 0xffff0000u);
            u32x4 wl; wl.x = cvt_pk_bf16(ra.x, ra.y); wl.y = cvt_pk_bf16(ra.z, ra.w); wl.z = cvt_pk_bf16(rb.x, rb.y); wl.w = cvt_pk_bf16(rb.z, rb.w);
            G = __builtin_amdgcn_mfma_f32_32x32x16_bf16(__builtin_bit_cast(bf16x8, wh), qf[d0], G, 0, 0, 0);
            G = __builtin_amdgcn_mfma_f32_32x32x16_bf16(__builtin_bit_cast(bf16x8, wl), qf[d0], G, 0, 0, 0);
        }
        float gv[16];
#pragma unroll
        for (int r = 0; r < 8; ++r) { const float own = G[r], oth = xchg_x32(own); const int n0 = (r & 3) + 8 * (r >> 2);
            gv[n0] = hi == 0 ? own : oth; gv[n0 + 4] = hi == 0 ? oth : own; }
        unsigned used = 0;
#pragma unroll
        for (int k = 0; k < 3; ++k) { int best = -1; float bv = -INFINITY;
#pragma unroll
            for (int n = 0; n < 16; ++n) if (!((used >> n) & 1u) && n < blk && (best < 0 || gv[n] > bv)) { best = n; bv = gv[n]; }
            if (best >= 0) used |= 1u << best; }
        selmask = used;
    }
    LAS unsigned char* scrb = lds + OFF_SCR + wave * 256; LAS float* al = (LAS float*)scrb; LAS float* li = al + 32; const LAS float* alh = al + 4 * hi; const LAS float* lih = li + 4 * hi;
    const int kk = wave * 8 + (lane & 7), cc = lane >> 3;
    const int kwr = cc * 1024 + kk * 16;
    int kvr, vwr; long vgo;
    if (DV == 128) { kvr = tid >> 4; const int c16 = tid & 15; vwr = kvr * 256 + ((((c16 >> 2) ^ (kvr & 3))) << 6) + (c16 & 3) * 16; vgo = 8 * c16; }
    else { kvr = tid >> 3; const int c8 = tid & 7; vwr = kvr * 128 + ((((c8 >> 2) ^ ((kvr >> 1) & 1))) << 6) + (c8 & 3) * 16; vgo = 8 * c8; }
    const int krd = hi * 1024 + c * 16;
    const int q4 = (lane & 15) >> 2, p4 = lane & 3, colhalf = (lane >> 4) & 1;
    int vrd, vq[NDV];
    if (DV == 128) { vrd = (4 * hi + q4) * 256 + 32 * colhalf + 8 * p4;
#pragma unroll
        for (int d0 = 0; d0 < NDV; ++d0) vq[d0] = (d0 ^ q4) << 6; }
    else { vrd = (4 * hi + q4) * 128 + 32 * colhalf + 8 * p4;
#pragma unroll
        for (int d0 = 0; d0 < NDV; ++d0) vq[d0] = (d0 ^ ((q4 >> 1) & 1)) << 6; }
    constexpr int VS = DV * 2 * 16, VH = DV * 2 * 8;
    u32x4 kst[NKC], vst[NVC];
    f32x16 o[NDV];
#pragma unroll
    for (int d0 = 0; d0 < NDV; ++d0) o[d0] = (f32x16){0.f, 0.f, 0.f, 0.f, 0.f, 0.f, 0.f, 0.f, 0.f, 0.f, 0.f, 0.f, 0.f, 0.f, 0.f, 0.f};
    float m_reg = -1e30f, l_reg = 0.f;
    constexpr bool SKIPMODE = (MODE == 3 || MODE == 4);
    if constexpr (SKIPMODE) {
#define FA_GLOAD(t) do { const long j0_ = kt_first + 64 * (t); \
        _Pragma("unroll") for (int i_ = 0; i_ < NKC; ++i_) { \
            if (MODE == 0 && i_ == 2) kst[i_] = *(const u32x4*)(k2base + (j0_ + kk) * k2stride + 8 * cc); \
            else kst[i_] = *(const u32x4*)(kbase + (j0_ + kk) * kstride + 8 * (8 * i_ + cc)); } \
        _Pragma("unroll") for (int i_ = 0; i_ < NVC; ++i_) vst[i_] = *(const u32x4*)(vbase + (j0_ + kvr + 32 * i_) * vstride + vgo); } while (0)
#define FA_LWRITE(bf) do { LAS unsigned char* kb_ = lds + (bf) * KMAXB; LAS unsigned char* vb_ = lds + OFF_V + (bf) * VMAXB; \
        _Pragma("unroll") for (int i_ = 0; i_ < NKC; ++i_) *(LAS u32x4*)(kb_ + kwr + i_ * 8192) = kst[i_]; \
        _Pragma("unroll") for (int i_ = 0; i_ < NVC; ++i_) *(LAS u32x4*)(vb_ + vwr + i_ * 8192) = vst[i_]; } while (0)
    FA_GLOAD(0); FA_LWRITE(0);
    __syncthreads();
    for (int t = 0; t < nt; ++t) {
        const int kt0 = kt_first + 64 * t;
        if (t + 1 < nt) FA_GLOAD(t + 1);
        bool act = true, rowmask = false, bandmask = false;
        if (MODE == 1 && t < 4 * blk) { const int n = t >> 2; const bool mine = (selmask >> n) & 1u; act = __ballot(mine) != 0ull; rowmask = true; }
        else if (!NOMASK) {
            act = kt0 <= qpos + 31 && (CAUSAL || kt0 + 63 + (int)WD >= qpos);
            bandmask = !(kt0 + 63 <= qpos && (CAUSAL || kt0 + (int)WD >= qpos + 31));
        }
        if (act) {
            LAS unsigned char* kb = lds + (t & 1) * KMAXB; LAS unsigned char* vb = lds + OFF_V + (t & 1) * VMAXB;
            f32x16 p0 = {0.f, 0.f, 0.f, 0.f, 0.f, 0.f, 0.f, 0.f, 0.f, 0.f, 0.f, 0.f, 0.f, 0.f, 0.f, 0.f}, p1 = p0;
            {
                bf16x8 k0[ND0], k1[ND0];
#pragma unroll
                for (int d0 = 0; d0 < ND0; ++d0) { k0[d0] = *(const LAS bf16x8*)(kb + krd + d0 * 2048); k1[d0] = *(const LAS bf16x8*)(kb + krd + d0 * 2048 + 512); }
#pragma unroll
                for (int d0 = 0; d0 < ND0; ++d0) { p0 = __builtin_amdgcn_mfma_f32_32x32x16_bf16(k0[d0], qf[d0], p0, 0, 0, 0); p1 = __builtin_amdgcn_mfma_f32_32x32x16_bf16(k1[d0], qf[d0], p1, 0, 0, 0); }
                __builtin_amdgcn_sched_group_barrier(0x100, 4, 0);
#pragma unroll
                for (int d0 = 0; d0 < ND0; ++d0) { if (d0 + 2 < ND0) __builtin_amdgcn_sched_group_barrier(0x100, 2, 0); __builtin_amdgcn_sched_group_barrier(0x008, 2, 0); }
            }
            if (rowmask) { if (!((selmask >> (t >> 2)) & 1u)) {
#pragma unroll
                for (int r = 0; r < 16; ++r) { p0[r] = -INFINITY; p1[r] = -INFINITY; } } }
            if (bandmask) { const int dq = qpos + c - kt0 - 4 * hi;
#pragma unroll
                for (int r = 0; r < 16; ++r) { const int cr = (r & 3) + 8 * (r >> 2);
                    if ((unsigned)(dq - cr) > WD) p0[r] = -INFINITY;
                    if ((unsigned)(dq - cr - 32) > WD) p1[r] = -INFINITY; } }
            float pmax = p0[0];
#pragma unroll
            for (int r = 1; r < 16; ++r) pmax = fmaxf(pmax, p0[r]);
#pragma unroll
            for (int r = 0; r < 16; ++r) pmax = fmaxf(pmax, p1[r]);
            pmax = max_x32(pmax);
            if (!__all((pmax - m_reg) * SCALE <= THR)) {
                const float mn = fmaxf(m_reg, pmax), alpha = __builtin_amdgcn_exp2f((m_reg - mn) * C2); m_reg = mn; l_reg *= alpha;
                if (hi == 0) al[c] = alpha;
                asm volatile("s_waitcnt lgkmcnt(0)" ::: "memory");
#pragma unroll
                for (int r = 0; r < 16; ++r) { const float f = alh[(r & 3) + 8 * (r >> 2)];
#pragma unroll
                    for (int d0 = 0; d0 < NDV; ++d0) o[d0][r] *= f; }
                asm volatile("s_waitcnt lgkmcnt(0)" ::: "memory");
            }
            const float mnl = -m_reg * C2; float ps = 0.f;
#pragma unroll
            for (int r = 0; r < 16; ++r) { p0[r] = __builtin_amdgcn_exp2f(fmaf(p0[r], C2, mnl)); p1[r] = __builtin_amdgcn_exp2f(fmaf(p1[r], C2, mnl)); ps += p0[r] + p1[r]; }
            l_reg += ps;
            bf16x8 pa[4];
#pragma unroll
            for (int s = 0; s < 4; ++s) { u32x4 w;
                if (s < 2) { w.x = cvt_pk_bf16(p0[8 * s + 0], p0[8 * s + 1]); w.y = cvt_pk_bf16(p0[8 * s + 2], p0[8 * s + 3]); w.z = cvt_pk_bf16(p0[8 * s + 4], p0[8 * s + 5]); w.w = cvt_pk_bf16(p0[8 * s + 6], p0[8 * s + 7]); }
                else { const int s2 = s - 2; w.x = cvt_pk_bf16(p1[8 * s2 + 0], p1[8 * s2 + 1]); w.y = cvt_pk_bf16(p1[8 * s2 + 2], p1[8 * s2 + 3]); w.z = cvt_pk_bf16(p1[8 * s2 + 4], p1[8 * s2 + 5]); w.w = cvt_pk_bf16(p1[8 * s2 + 6], p1[8 * s2 + 7]); }
                pa[s] = __builtin_bit_cast(bf16x8, w); }
            {
                s16x4 lo[4 * NDV], hv[4 * NDV];
#pragma unroll
                for (int s = 0; s < 4; ++s)
#pragma unroll
                    for (int d0 = 0; d0 < NDV; ++d0) { lo[s * NDV + d0] = vtr(vb + vrd + vq[d0] + s * VS); hv[s * NDV + d0] = vtr(vb + vrd + vq[d0] + s * VS + VH); }
#pragma unroll
                for (int s = 0; s < 4; ++s)
#pragma unroll
                    for (int d0 = 0; d0 < NDV; ++d0) { const s16x4 a_ = lo[s * NDV + d0], b_ = hv[s * NDV + d0];
                        const bf16x8 vf = {a_[0], a_[1], a_[2], a_[3], b_[0], b_[1], b_[2], b_[3]};
                        o[d0] = __builtin_amdgcn_mfma_f32_32x32x16_bf16(pa[s], vf, o[d0], 0, 0, 0); }
                __builtin_amdgcn_sched_group_barrier(0x100, 4, 1);
#pragma unroll
                for (int i = 0; i < 4 * NDV; ++i) { if (i + 2 < 4 * NDV) __builtin_amdgcn_sched_group_barrier(0x100, 2, 1); __builtin_amdgcn_sched_group_barrier(0x008, 1, 1); }
            }
        }
        if (t + 1 < nt) FA_LWRITE((t + 1) & 1);
        __syncthreads();
    }
#undef FA_GLOAD
#undef FA_LWRITE
    } else {
    unsigned kvo[NKC], vvo[NVC];
#pragma unroll
    for (int i_ = 0; i_ < NKC; ++i_) kvo[i_] = (MODE == 0 && i_ == 2) ? (unsigned)(kk * k2stride + 8 * cc) * 2u : (unsigned)(kk * kstride + 8 * (8 * i_ + cc)) * 2u;
#pragma unroll
    for (int i_ = 0; i_ < NVC; ++i_) vvo[i_] = (unsigned)((kvr + 32 * i_) * vstride + vgo) * 2u;
#define FA_GLOAD_K(t) do { const long j0_ = kt_first + 64 * (t); const char* kb0_ = (const char*)(kbase + j0_ * kstride); const char* kb2_ = (const char*)(k2base + j0_ * k2stride); \
        _Pragma("unroll") for (int i_ = 0; i_ < NKC; ++i_) { \
            if (MODE == 0 && i_ == 2) kst[i_] = *(const u32x4*)(kb2_ + kvo[i_]); \
            else kst[i_] = *(const u32x4*)(kb0_ + kvo[i_]); } } while (0)
#define FA_GLOAD_V(t) do { const long j0_ = kt_first + 64 * (t); const char* vb0_ = (const char*)(vbase + j0_ * vstride); \
        _Pragma("unroll") for (int i_ = 0; i_ < NVC; ++i_) vst[i_] = *(const u32x4*)(vb0_ + vvo[i_]); } while (0)
#define FA_LWRITE_K(kofs) do { LAS unsigned char* kb_ = lds + (kofs); \
        _Pragma("unroll") for (int i_ = 0; i_ < NKC; ++i_) *(LAS u32x4*)(kb_ + kwr + i_ * 8192) = kst[i_]; } while (0)
#define FA_LWRITE_V(bf) do { LAS unsigned char* vb_ = lds + OFF_V + (bf) * VMAXB; \
        _Pragma("unroll") for (int i_ = 0; i_ < NVC; ++i_) *(LAS u32x4*)(vb_ + vwr + i_ * 8192) = vst[i_]; } while (0)
#define FA_QK_H(P, kofs, koff) \
        { int ka_ = (kofs) + (koff) + krd; asm volatile("" : "+v"(ka_)); const LAS unsigned char* kb_ = lds + ka_; bf16x8 kf_[ND0]; \
          P = (f32x16){0.f, 0.f, 0.f, 0.f, 0.f, 0.f, 0.f, 0.f, 0.f, 0.f, 0.f, 0.f, 0.f, 0.f, 0.f, 0.f}; \
          _Pragma("unroll") for (int d0 = 0; d0 < ND0; ++d0) kf_[d0] = *(const LAS bf16x8*)(kb_ + d0 * 2048); \
          _Pragma("unroll") for (int d0 = 0; d0 < ND0; ++d0) P = __builtin_amdgcn_mfma_f32_32x32x16_bf16(kf_[d0], qf[d0], P, 0, 0, 0); }
#define FA_KPRE(kofs, koff) \
        { int ka_ = (kofs) + (koff) + krd; asm volatile("" : "+v"(ka_)); const LAS unsigned char* kb_ = lds + ka_; kpre0 = *(const LAS bf16x8*)(kb_); kpre1 = *(const LAS bf16x8*)(kb_ + 2048); }
#define FA_QK_HP(P, kofs, koff) \
        { int ka_ = (kofs) + (koff) + krd; asm volatile("" : "+v"(ka_)); const LAS unsigned char* kb_ = lds + ka_; bf16x8 kf_[ND0]; kf_[0] = kpre0; kf_[1] = kpre1; \
          P = (f32x16){0.f, 0.f, 0.f, 0.f, 0.f, 0.f, 0.f, 0.f, 0.f, 0.f, 0.f, 0.f, 0.f, 0.f, 0.f, 0.f}; \
          _Pragma("unroll") for (int d0 = 2; d0 < ND0; ++d0) kf_[d0] = *(const LAS bf16x8*)(kb_ + d0 * 2048); \
          _Pragma("unroll") for (int d0 = 0; d0 < ND0; ++d0) P = __builtin_amdgcn_mfma_f32_32x32x16_bf16(kf_[d0], qf[d0], P, 0, 0, 0); }
#define FA_VPRE(bf, s0) \
        { int a0_ = OFF_V + (bf) * VMAXB + (s0) * VS + vrd + vq[0], a1_ = OFF_V + (bf) * VMAXB + (s0) * VS + vrd + vq[1]; asm volatile("" : "+v"(a0_), "+v"(a1_)); \
          vplo0 = vtr(lds + a0_); vphv0 = vtr(lds + a0_ + VH); vplo1 = vtr(lds + a1_); vphv1 = vtr(lds + a1_ + VH); }
#define FA_PV_HP(bf, s0) \
        { s16x4 lo_[2 * NDV], hv_[2 * NDV]; const LAS unsigned char* vbd_[NDV]; \
          _Pragma("unroll") for (int d0 = 0; d0 < NDV; ++d0) { int a_ = OFF_V + (bf) * VMAXB + (s0) * VS + vrd + vq[d0]; asm volatile("" : "+v"(a_)); vbd_[d0] = lds + a_; } \
          lo_[0] = vplo0; hv_[0] = vphv0; lo_[1] = vplo1; hv_[1] = vphv1; \
          _Pragma("unroll") for (int s_ = 0; s_ < 2; ++s_) _Pragma("unroll") for (int d0 = 0; d0 < NDV; ++d0) { if (s_ * NDV + d0 >= 2) { lo_[s_ * NDV + d0] = vtr(vbd_[d0] + s_ * VS); hv_[s_ * NDV + d0] = vtr(vbd_[d0] + s_ * VS + VH); } } \
          _Pragma("unroll") for (int s_ = 0; s_ < 2; ++s_) _Pragma("unroll") for (int d0 = 0; d0 < NDV; ++d0) { const s16x4 a_ = lo_[s_ * NDV + d0], b_ = hv_[s_ * NDV + d0]; \
              const bf16x8 vf_ = {a_[0], a_[1], a_[2], a_[3], b_[0], b_[1], b_[2], b_[3]}; o[d0] = __builtin_amdgcn_mfma_f32_32x32x16_bf16(pa[s_], vf_, o[d0], 0, 0, 0); } }
#define FA_QKP_EXP_SGB \
        { constexpr int NV_ = (50 + ND0 - 1) / ND0, NT_ = (16 + ND0 - 1) / ND0; \
          _Pragma("unroll") for (int d0 = 0; d0 < ND0; ++d0) { if (d0 + 2 < ND0) __builtin_amdgcn_sched_group_barrier(0x100, 1, 0); __builtin_amdgcn_sched_group_barrier(0x008, 1, 0); \
              __builtin_amdgcn_sched_group_barrier(0x002, NV_, 0); __builtin_amdgcn_sched_group_barrier(0x400, NT_, 0); } \
          __builtin_amdgcn_sched_group_barrier(0x100, 4, 0); }
#define FA_PVP_SGB \
        { _Pragma("unroll") for (int i_ = 0; i_ < 2 * NDV; ++i_) { if (i_ + 2 < 2 * NDV) __builtin_amdgcn_sched_group_barrier(0x100, 2, 1); __builtin_amdgcn_sched_group_barrier(0x008, 1, 1); } \
          __builtin_amdgcn_sched_group_barrier(0x100, 2, 1); }
#define FA_QK_SGB \
        { __builtin_amdgcn_sched_group_barrier(0x100, 2, 0); \
          _Pragma("unroll") for (int d0 = 0; d0 < ND0; ++d0) { if (d0 + 2 < ND0) __builtin_amdgcn_sched_group_barrier(0x100, 1, 0); __builtin_amdgcn_sched_group_barrier(0x008, 1, 0); } }
#define FA_QK_EXP_SGB \
        { constexpr int NV_ = (48 + ND0 - 1) / ND0, NT_ = (16 + ND0 - 1) / ND0; \
          __builtin_amdgcn_sched_group_barrier(0x100, 2, 0); \
          _Pragma("unroll") for (int d0 = 0; d0 < ND0; ++d0) { if (d0 + 2 < ND0) __builtin_amdgcn_sched_group_barrier(0x100, 1, 0); __builtin_amdgcn_sched_group_barrier(0x008, 1, 0); \
              __builtin_amdgcn_sched_group_barrier(0x002, NV_, 0); __builtin_amdgcn_sched_group_barrier(0x400, NT_, 0); } }
#define FA_EXP_H(P) \
        { const float mnl_ = -m_reg * C2; float ps_ = 0.f; \
          _Pragma("unroll") for (int r = 0; r < 16; ++r) { P[r] = __builtin_amdgcn_exp2f(fmaf(P[r], C2, mnl_)); ps_ += P[r]; } \
          l_reg += ps_; \
          _Pragma("unroll") for (int s_ = 0; s_ < 2; ++s_) { u32x4 w_; \
              w_.x = cvt_pk_bf16(P[8 * s_ + 0], P[8 * s_ + 1]); w_.y = cvt_pk_bf16(P[8 * s_ + 2], P[8 * s_ + 3]); w_.z = cvt_pk_bf16(P[8 * s_ + 4], P[8 * s_ + 5]); w_.w = cvt_pk_bf16(P[8 * s_ + 6], P[8 * s_ + 7]); pa[s_] = __builtin_bit_cast(bf16x8, w_); } }
#define FA_MASK_H(P, tt, hh) \
        { const int tt_ = (tt); bool rowm_ = false, bandm_ = false; const int kt0_ = kt_first + 64 * tt_; \
          if (MODE == 1 && tt_ < 4 * blk) rowm_ = true; else if (!NOMASK) bandm_ = !(kt0_ + 63 <= qpos && (CAUSAL || kt0_ + (int)WD >= qpos + 31)); \
          if (rowm_) { if (!((selmask >> (tt_ >> 2)) & 1u)) { _Pragma("unroll") for (int r = 0; r < 16; ++r) P[r] = -INFINITY; } } \
          if (bandm_) { const int dq_ = qpos + c - kt0_ - 4 * hi - 32 * (hh); \
              _Pragma("unroll") for (int r = 0; r < 16; ++r) { if ((unsigned)(dq_ - ((r & 3) + 8 * (r >> 2))) > WD) P[r] = -INFINITY; } } }
#define FA_MAX_H(P, PM) \
        { float pm_ = fmaxf(P[0], P[1]); \
          _Pragma("unroll") for (int r = 2; r < 16; r += 2) pm_ = fmaxf(fmaxf(pm_, P[r]), P[r + 1]); \
          auto rr_ = __builtin_amdgcn_permlane32_swap(__float_as_uint(pm_), __float_as_uint(pm_), false, false); PM = fmaxf(__uint_as_float(rr_[0]), __uint_as_float(rr_[1])); }
#define FA_DECIDE(PM) \
        { if (!__all(((PM) - m_reg) * SCALE <= THR)) { \
              const float mn_ = fmaxf(m_reg, (PM)), alpha_ = __builtin_amdgcn_exp2f((m_reg - mn_) * C2); m_reg = mn_; l_reg *= alpha_; \
              if (hi == 0) al[c] = alpha_; \
              asm volatile("s_waitcnt lgkmcnt(0)" ::: "memory"); \
              _Pragma("unroll") for (int r = 0; r < 16; ++r) { const float f_ = alh[(r & 3) + 8 * (r >> 2)]; \
                  _Pragma("unroll") for (int d0 = 0; d0 < NDV; ++d0) o[d0][r] *= f_; } \
              asm volatile("s_waitcnt lgkmcnt(0)" ::: "memory"); } }
#define FA_PV_H(bf, s0) \
        { s16x4 lo_[2 * NDV], hv_[2 * NDV]; const LAS unsigned char* vbd_[NDV]; \
          _Pragma("unroll") for (int d0 = 0; d0 < NDV; ++d0) { int a_ = OFF_V + (bf) * VMAXB + (s0) * VS + vrd + vq[d0]; asm volatile("" : "+v"(a_)); vbd_[d0] = lds + a_; }     \
          _Pragma("unroll") for (int s_ = 0; s_ < 2; ++s_) _Pragma("unroll") for (int d0 = 0; d0 < NDV; ++d0) { lo_[s_ * NDV + d0] = vtr(vbd_[d0] + s_ * VS); hv_[s_ * NDV + d0] = vtr(vbd_[d0] + s_ * VS + VH); } \
          _Pragma("unroll") for (int s_ = 0; s_ < 2; ++s_) _Pragma("unroll") for (int d0 = 0; d0 < NDV; ++d0) { const s16x4 a_ = lo_[s_ * NDV + d0], b_ = hv_[s_ * NDV + d0]; \
              const bf16x8 vf_ = {a_[0], a_[1], a_[2], a_[3], b_[0], b_[1], b_[2], b_[3]}; o[d0] = __builtin_amdgcn_mfma_f32_32x32x16_bf16(pa[s_], vf_, o[d0], 0, 0, 0); } \
          __builtin_amdgcn_sched_group_barrier(0x100, 4, 1); \
          _Pragma("unroll") for (int i_ = 0; i_ < 2 * NDV; ++i_) { if (i_ + 2 < 2 * NDV) __builtin_amdgcn_sched_group_barrier(0x100, 2, 1); __builtin_amdgcn_sched_group_barrier(0x008, 1, 1); } }
    {
        f32x16 pA, pB;
        bf16x8 kpre0, kpre1; s16x4 vplo0, vphv0, vplo1, vphv1;
        FA_GLOAD_K(0); FA_GLOAD_V(0); FA_LWRITE_K(0); FA_LWRITE_V(0);
        if (nt > 1) { FA_GLOAD_K(1); FA_LWRITE_K(KMAXB); }
        __syncthreads();
        { FA_QK_H(pA, 0, 0) FA_QK_SGB }
        float pmA, pmB;
        FA_MASK_H(pA, 0, 0)
        FA_MAX_H(pA, pmA)
        FA_KPRE(0, 512)
        int kc = 0, kn = KMAXB, kw = 2 * KMAXB;
        const int ntw = CAUSAL ? nt - 3 + (wave >> 1) : nt;
        for (int t = 0; t < nt; ++t) {
            if (t + 2 < nt) FA_GLOAD_K(t + 2);
            if (t + 1 < nt) FA_GLOAD_V(t + 1);
            if (t < ntw) {
            bf16x8 pa[2];
            FA_DECIDE(pmA)
            __builtin_amdgcn_sched_barrier(0);
            { FA_QK_HP(pB, kc, 512) FA_EXP_H(pA) FA_VPRE(t & 1, 0) FA_QKP_EXP_SGB }
            __builtin_amdgcn_sched_barrier(0);
            FA_MASK_H(pB, t, 1)
            __builtin_amdgcn_sched_barrier(0);
            { FA_PV_HP(t & 1, 0) FA_MAX_H(pB, pmB) FA_KPRE(kn, 0) FA_PVP_SGB }
            __builtin_amdgcn_sched_barrier(0);
            FA_DECIDE(pmB)
            __builtin_amdgcn_sched_barrier(0);
            if (t + 1 < ntw) { FA_QK_HP(pA, kn, 0) FA_EXP_H(pB) FA_VPRE(t & 1, 2) FA_QKP_EXP_SGB }
            else { FA_EXP_H(pB) FA_VPRE(t & 1, 2) }
            __builtin_amdgcn_sched_barrier(0);
            if (t + 1 < ntw) FA_MASK_H(pA, t + 1, 0)
            __builtin_amdgcn_sched_barrier(0);
            { FA_PV_HP(t & 1, 2) FA_MAX_H(pA, pmA) FA_KPRE(kn, 512) FA_PVP_SGB }
            __builtin_amdgcn_sched_barrier(0);
            }
            if (t + 2 < nt) FA_LWRITE_K(kw);
            if (t + 1 < nt) FA_LWRITE_V((t + 1) & 1);
            __syncthreads();
            { const int tmp_ = kc; kc = kn; kn = kw; kw = tmp_; }
        }
    }
#undef FA_GLOAD_K
#undef FA_GLOAD_V
#undef FA_LWRITE_K
#undef FA_LWRITE_V
#undef FA_QK_H
#undef FA_QK_SGB
#undef FA_KPRE
#undef FA_QK_HP
#undef FA_VPRE
#undef FA_PV_HP
#undef FA_QKP_EXP_SGB
#undef FA_PVP_SGB
#undef FA_QK_EXP_SGB
#undef FA_EXP_H
#undef FA_MASK_H
#undef FA_MAX_H
#undef FA_DECIDE
#undef FA_PV_H
    }
    constexpr int CPR = DV / 8, NGI = 32 * CPR / 64;
    u32x4 gpre[NGI];
    if (MODE != 4) {
#pragma unroll
        for (int i = 0; i < NGI; ++i) { const int q = lane + 64 * i, row = q / CPR, ch = q % CPR; gpre[i] = *(const u32x4*)(H + (tok0 + tokstep * row) * LDH + ycol + ch * 8); }
    }
    const float lt = sum_x32(l_reg);
    float fin = 1.0f / lt;
    const float lse = m_reg * SCALE + __logf(lt);
    if (MODE == 3) fin *= 1.0f / (1.0f + __expf(sinks[hh] - lse));
    if (hi == 0) li[c] = fin;
    asm volatile("s_waitcnt lgkmcnt(0)" ::: "memory");
    LAS bf16_t* stg = (LAS bf16_t*)(lds + OFF_STG + wave * 8192); LAS bf16_t* stgl = stg + 4 * hi * DV + c;
#pragma unroll
    for (int r = 0; r < 16; ++r) { const int cr = (r & 3) + 8 * (r >> 2); const float f = lih[cr];
#pragma unroll
        for (int d0 = 0; d0 < NDV; ++d0) stgl[cr * DV + 32 * d0] = (bf16_t)(cvt_pk_bf16(o[d0][r] * f, 0.f) & 0xffffu); }
    asm volatile("s_waitcnt lgkmcnt(0)" ::: "memory");
#pragma unroll
    for (int i = 0; i < NGI; ++i) {
        const int q = lane + 64 * i, row = q / CPR, ch = q % CPR;
        const u32x4 v = *(const LAS u32x4*)(stg + row * DV + ch * 8);
        const long tok = tok0 + tokstep * row;
        if (MODE == 4) { *(u32x4*)((bf16_t*)(ws + ws_op(pat)) + (size_t)tok * 768 + hh * 128 + ch * 8) = v; }
        else {
            bf16_t* yp = H + tok * LDH + ycol + ch * 8; const u32x4 g = gpre[i]; u32x4 w;
#define FA_GATE(vv, gg) cvt_pk_bf16(__uint_as_float((vv) << 16) * silu(__uint_as_float((gg) << 16)), __uint_as_float((vv) & 0xffff0000u) * silu(__uint_as_float((gg) & 0xffff0000u)))
            w.x = FA_GATE(v.x, g.x); w.y = FA_GATE(v.y, g.y); w.z = FA_GATE(v.z, g.z); w.w = FA_GATE(v.w, g.w);
#undef FA_GATE
            *(u32x4*)yp = w;
        }
    }
    if (MODE == 4 && hi == 0) ((float*)(ws + WS_LSE))[((size_t)pat * T + tok0 + tokstep * c) * 6 + hh] = lse;
}
}

#define XB_TMO      128
#define XB_XCNT(j)  (256  + 64 * (j))
#define XB_XSUB(j)  (1280 + 64 * (j))
#define XB_XGEN(j)  (2304 + 64 * (j))
#define XB_TOP      3328
#define XB_TOPGEN   3392
#define XCD_BAR_WORDS 3456
#define XB_SPIN_CAP (1u << 22)
__device__ __forceinline__ unsigned xb_ld(unsigned* p)              { return __hip_atomic_load(p, __ATOMIC_RELAXED, __HIP_MEMORY_SCOPE_AGENT); }
__device__ __forceinline__ unsigned xb_add(unsigned* p, unsigned v) { return __hip_atomic_fetch_add(p, v, __ATOMIC_RELAXED, __HIP_MEMORY_SCOPE_AGENT); }
__device__ __forceinline__ unsigned xb_xcc_id() { return (unsigned)__builtin_amdgcn_s_getreg((3 << 11) | 20) & 0xFu; }
#define XB_SPIN(cond, bar) do { unsigned _sp = 0; while (cond) { __builtin_amdgcn_s_sleep(1); \
    if ((++_sp & 255u) == 0u) { if (xb_ld(&(bar)[XB_TMO])) break; if (_sp > XB_SPIN_CAP) { atomicAdd(&(bar)[XB_TMO], 1u); break; } } } } while (0)
__device__ __forceinline__ void xcd_barrier_complete(unsigned* bar, unsigned x, unsigned& nloc, unsigned& nx) {
    const unsigned G = gridDim.x; unsigned sum, cnt, mine, sp = 0u;
    for (;;) {
        sum = 0u; cnt = 0u; mine = 0u;
#pragma unroll
        for (unsigned j = 0; j < 16; ++j) { const unsigned c = xb_ld(&bar[XB_XCNT(j)]); sum += c; cnt += (c > 0u) ? 1u : 0u; mine = (j == x) ? c : mine; }
        if (sum == G) break;
        __builtin_amdgcn_s_sleep(1);
        if ((++sp & 255u) == 0u) { if (xb_ld(&bar[XB_TMO])) break; if (sp > XB_SPIN_CAP) { atomicAdd(&bar[XB_TMO], 1u); break; } }
    }
    nloc = mine > 0u ? mine : 1u; nx = cnt > 0u ? cnt : 1u;
}
__device__ __forceinline__ void grid_barrier(unsigned* bar, volatile LAS unsigned* st, const int wave_s) {
    asm volatile("s_waitcnt vmcnt(0)" ::: "memory");
    __syncthreads();
    if (wave_s == 0 && lane_id() == 0) {
        const unsigned x = xb_xcc_id();
        __builtin_amdgcn_s_waitcnt(0);
        unsigned nloc = st[0], nx = st[1];
        if (nloc == 0u) { xcd_barrier_complete(bar, x, nloc, nx); st[0] = nloc; st[1] = nx; }
        const unsigned old = xb_add(&bar[XB_XSUB(x)], 1u);
        const unsigned gen = old / nloc;
        if (old + 1u == (gen + 1u) * nloc) {
            __builtin_amdgcn_fence(__ATOMIC_RELEASE, "agent");
            asm volatile("s_waitcnt vmcnt(0)" ::: "memory");
            const unsigned og = xb_add(&bar[XB_TOP], 1u);
            const unsigned tg = og / nx;
            if (og + 1u == (tg + 1u) * nx) {
#pragma unroll
                for (unsigned j = 0; j < 16; ++j) (void)xb_add(&bar[XB_XGEN(j)], 1u);
            } else XB_SPIN(xb_ld(&bar[XB_XGEN(x)]) == gen, bar);
            __builtin_amdgcn_fence(__ATOMIC_ACQUIRE, "agent");
            asm volatile("s_waitcnt vmcnt(0)" ::: "memory");
        } else {
            XB_SPIN(xb_ld(&bar[XB_XGEN(x)]) == gen, bar);
            __builtin_amdgcn_fence(__ATOMIC_ACQUIRE, "agent");
            asm volatile("s_waitcnt vmcnt(0)" ::: "memory");
        }
    }
    __syncthreads();
}

__device__ __forceinline__ int opaque_tid(int wave_s) { int t = wave_s * 64 + lane_id(); asm volatile("" : "+v"(t)); return t; }

constexpr int LDS_BYTES = 155648;
static_assert(fa::LDS_NEED <= LDS_BYTES - 64, "LDS map");
__global__ void __launch_bounds__(512, 2) mega(Args args) {
    extern __shared__ __attribute__((aligned(16))) unsigned char lds_raw[];
    LAS unsigned char* lds = (LAS unsigned char*)lds_raw;
    const int G = gridDim.x, NGW = G * 8;
    const int wave_s = __builtin_amdgcn_readfirstlane((int)threadIdx.x >> 6);
#define PHASE_IDS const int tid = opaque_tid(wave_s), lane = tid & 63, wave = wave_s, gw = blockIdx.x * 8 + wave; (void)lane; (void)gw;
#define KA() ({ auto p_ = __builtin_amdgcn_kernarg_segment_ptr(); asm volatile("" : "+s"(p_)); (const __attribute__((address_space(4))) Args*)p_; })
    unsigned char* ws = KA()->ws;
    const int lo = KA()->ph_lo, hi = KA()->ph_hi;
#define IN(k) (lo <= (k) && (k) < hi)
#define SEAM(k) do { if (IN(k) && IN((k) + 1)) { grid_barrier((unsigned*)(ws + WS_CTL) + 1024, (volatile LAS unsigned*)(lds + LDS_BYTES - 64), wave_s); } } while (0)
    if (lane_id() < 16 && wave_s == 0) ((LAS unsigned*)(lds + LDS_BYTES - 64))[lane_id()] = 0u;
    __syncthreads();
    if (hi - lo > 1 && wave_s == 0 && lane_id() == 0) (void)xb_add((unsigned*)(ws + WS_CTL) + 1024 + XB_XCNT(xb_xcc_id()), 1u);
    if (lo < 0) cg::this_grid().sync();
#define W1E ((bf16_t*)(ws + WS_W1E))
#define WUQ ((bf16_t*)(ws + WS_WUQ))
#define WUKV ((bf16_t*)(ws + WS_WUKV))
#define WMKE ((bf16_t*)(ws + WS_WMKE))
#define WOE ((bf16_t*)(ws + WS_WOE))
#define W1O ((bf16_t*)(ws + WS_W1O))
#define WMKO ((bf16_t*)(ws + WS_WMKO))
#define WOO ((bf16_t*)(ws + WS_WOO))
#define XB ((bf16_t*)(ws + WS_R1))
#define QA ((bf16_t*)KA()->out)
#define KVA ((bf16_t*)(ws + WS_KVA))
#define H ((bf16_t*)(ws + WS_H))
#define MEMB ((bf16_t*)(ws + WS_MEMB))
#define MKVE ((bf16_t*)(ws + WS_MKVE))
#define MKVO ((bf16_t*)(ws + WS_MKVO))
#define CS64 ((f32x2*)(ws + WS_CS64))
#define CS32 ((f32x2*)(ws + WS_CS32))
#define CS16 ((f32x2*)(ws + WS_CS16))
#define RS0 ((float*)(ws + WS_RS0))
#define SSQQ ((float*)(ws + WS_SSQQ))
#define SSQKV ((float*)(ws + WS_SSQKV))
#define SSQ1 ((float*)(ws + WS_SSQ1))
#define SSQ2 ((float*)(ws + WS_SSQ2))
#define RSMEM ((float*)(ws + WS_RSMEM))
#define KMEAN ((float*)(ws + WS_KMEAN))
    if (IN(0)) {
        PHASE_IDS
        LAS float* scr = (LAS float*)(lds + wave * 16640);
        constexpr int I0 = 32 * 112, I1 = 8 * 24, I2 = 4 * 32, I3 = 32 * 16, I6 = 32 * 16;
        constexpr int total = I0 + I1 + I2 + I3 + I6;
        for (int it = gw; it < total; it += NGW) {
            int r = it;
            if (r < I0) { transpose_item(KA()->in[3], 2048, 6976, W1E, KA()->in[2], 0, scr, r, 112, lane); continue; } r -= I0;
            if (r < I1) { transpose_item(KA()->in[5], 512, 1536, WUQ, KA()->in[4], 1, scr, r, 24, lane); continue; } r -= I1;
            if (r < I2) { transpose_item(KA()->in[7], 256, 2048, WUKV, KA()->in[6], 2, scr, r, 32, lane); continue; } r -= I2;
            if (r < I3) { transpose_item(KA()->in[9], 2048, 1024, WMKE, KA()->in[8], 3, scr, r, 16, lane); continue; } r -= I3;
            transpose_item(KA()->in[15], 2048, 1024, WMKO, KA()->in[14], 6, scr, r, 16, lane);
        }
        for (int m = gw - total % NGW + (gw < total % NGW ? NGW : 0); m < T + NB * NMEM; m += NGW) {
            if (m < T) row_to_bf16(KA()->in[0] + (size_t)m * DM, XB + (size_t)m * DM, RS0 + m, lane);
            else { const int mm = m - T; row_to_bf16(KA()->in[1] + (size_t)mm * DM, MEMB + (size_t)mm * DM, RSMEM + mm, lane); }
        }
        const int gt = blockIdx.x * 512 + tid, NGT = G * 512;
        for (int i = gt; i < SEQ * 56; i += NGT) {
            const int pos = i / 56, j = i - pos * 56; int rot, fi; f32x2* dst;
            if (j < 32) { rot = 64; fi = j; dst = CS64 + pos * 32 + fi; } else if (j < 48) { rot = 32; fi = j - 32; dst = CS32 + pos * 16 + fi; } else { rot = 16; fi = j - 48; dst = CS16 + pos * 8 + fi; }
            const float inv = 1.0f / powf(500000.0f, (float)(2 * fi) / (float)rot);
            const float ang = (float)pos * inv; float sn, cs; sincosf(ang, &sn, &cs);
            *dst = (f32x2){cs, sn};
        }
        for (int i = gt; i < T; i += NGT) { SSQQ[i] = 0.f; SSQKV[i] = 0.f; SSQ1[i] = 0.f; SSQ2[i] = 0.f; }
        if (gt < 64) ((unsigned*)(ws + WS_CTL))[gt] = 0u;
    }
    SEAM(0);
    if (IN(1)) {
        EpiBF<0> E{H, LDH0, RS0, nullptr, 0.f, SSQQ, SSQKV, CS64, CS32, CS16};
        run_gemm(lds, XB, DM, W1E, T, LDH0, DM, E, 0, wave_s);
    }
    SEAM(1);
    if (IN(2)) {
        PHASE_IDS
        for (int it0 = (int)blockIdx.x * 2; it0 < 512; it0 += G * 2) {
            const int it = it0 + (wave >> 2), q = wave & 3;
            const int b = it >> 7, n = (it >> 3) & 15, hh = it & 7;
            const bf16_t* kp = H + (size_t)(b * SEQ + n * 256 + q * 64) * LDH0 + E_KB + hh * 128 + 2 * lane; float s0 = 0.f, s1 = 0.f;
#pragma unroll 16
            for (int j = 0; j < 64; ++j) { const unsigned w = *(const unsigned*)(kp + (size_t)j * LDH0); s0 += __uint_as_float(w << 16); s1 += __uint_as_float(w & 0xffff0000u); }
            LAS float* part = (LAS float*)lds + wave * 128; part[2 * lane] = s0; part[2 * lane + 1] = s1;
            __syncthreads();
            if (q == 0) {
                const LAS float* p0 = (const LAS float*)lds + wave * 128 + 2 * lane;
                const float t0 = ((p0[0] + p0[128]) + p0[256]) + p0[384], t1 = ((p0[1] + p0[129]) + p0[257]) + p0[385];
                float* km = KMEAN + ((size_t)((b * 8 + hh) * 16 + n)) * 128 + 2 * lane; km[0] = t0 * (1.f / 256.f); km[1] = t1 * (1.f / 256.f);
            }
            __syncthreads();
        }
        { EpiBF<4> E{MKVE, 1024, RSMEM, nullptr, 0.f, nullptr, nullptr, CS64, CS32, CS16}; run_gemm(lds, MEMB, DM, WMKE, NB * NMEM, 1024, DM, E, 0, wave_s); }
        { EpiBF<4> E{MKVO, 1024, RSMEM, nullptr, 0.f, nullptr, nullptr, CS64, CS32, CS16}; run_gemm(lds, MEMB, DM, WMKO, NB * NMEM, 1024, DM, E, 240, wave_s); }
        { EpiBF<1> E{QA, 1536, nullptr, SSQQ, 1.f / 512.f, nullptr, nullptr, CS64, CS32, CS16}; pg8::StaticOrder S; S.init(T, 1536, G == 256 ? 224 : G, G == 256 ? (int)blockIdx.x - 32 : (int)blockIdx.x); run_gemm_s(lds, H + E_CQ, LDH0, WUQ, T, 1536, 512, E, S, wave_s); }
                { EpiBF<2> E{KVA, 2048, nullptr, SSQKV, 1.f / 256.f, nullptr, nullptr, CS64, CS32, CS16};
          pg8::StaticOrder S; int c2 = (int)blockIdx.x;
          if (G == 256) { c2 -= 32; if (c2 >= 0) c2 = c2 >= 160 ? c2 - 160 : c2 + 64; }
          S.init(T, 2048, G == 256 ? 224 : G, c2); run_gemm_s(lds, H + E_CKV, LDH0, WUKV, T, 2048, 256, E, S, wave_s); }
    }
    SEAM(2);
    if (IN(3)) {
        PHASE_IDS
        unsigned* ctr = (unsigned*)(ws + WS_CTL); volatile LAS unsigned* qw = (volatile LAS unsigned*)(lds + fa::OFF_Q);
        for (;;) {
            if (tid == 0) qw[0] = atomicAdd(ctr, 1u);
            __syncthreads();
            const int it = __builtin_amdgcn_readfirstlane((int)qw[0]);
            __syncthreads();
            if (it >= 1280 + 704) break;
            int ia = it, ic = -1;
            if (it >= 256) { const int j = it - 256, blk = j / 27, r = j - blk * 27, nc = (r * 11) / 27; if (((r + 1) * 11) / 27 > nc) ic = blk * 11 + nc; else ia = 256 + blk * 16 + (r - nc); }
            if (ic >= 0) {
                constexpr int I4 = 40 * 32, I5 = 32 * 100;
                LAS float* scr = (LAS float*)(lds + (wave < 6 ? wave * 16640 : 108800 + (wave - 6) * 16640));
                int r = ic * 8 + wave;
                int ln = lane_id(); asm volatile("" : "+v"(ln));
                if (r < I4) transpose_item(KA()->in[10], 2560, 2048, WOE, nullptr, 4, scr, r, 32, ln);
                else if (r < I4 + I5) transpose_item(KA()->in[12], 2048, 6400, W1O, KA()->in[11], 5, scr, r - I4, 100, ln);
                else transpose_item(KA()->in[16], 2304, 2048, WOO, nullptr, 7, scr, r - I4 - I5, 32, ln);
                continue;
            }
            if (ia < 1024) { const int item = (ia & ~63) / 2 + (ia & 31); if (((ia >> 5) & 1) == 0) fa::attn_item<0>(lds, ws, (const float*)KA()->out, item, wave_s); else fa::attn_item<1>(lds, ws, KA()->in[13], item, wave_s); }
            else fa::attn_item<2>(lds, ws, KA()->in[13], ia - 1024, wave_s);
        }
    }
    SEAM(3);
    if (IN(4)) {
        EpiRes<true, false> E{XB, nullptr, XB, DM, SSQ1};
        run_gemm(lds, H + E_G, LDH0, WOE, T, DM, 2560, E, 0, wave_s, WGM_OUT);
    }
    SEAM(4);
    if (IN(5)) {
        EpiBF<3> E{H, LDH1, nullptr, SSQ1, 1.f / DM, nullptr, nullptr, CS64, CS32, CS16};
        run_gemm(lds, XB, DM, W1O, T, 6144, DM, E, 0, wave_s);
    }
    SEAM(5);
    if (IN(6)) {
        PHASE_IDS
        if (blockIdx.x < 64) {
            EpiBF<3> E{H, LDH1, nullptr, SSQ1, 1.f / DM, nullptr, nullptr, CS64, CS32, CS16}; TailUnits S1{(int)blockIdx.x, G, 64, 24};
            run_gemm_s(lds, XB, DM, W1O, T, LDH1, DM, E, S1, wave_s);
            asm volatile("s_waitcnt vmcnt(0)" ::: "memory"); __syncthreads();
            if (tid == 0) { __builtin_amdgcn_fence(__ATOMIC_RELEASE, "agent"); asm volatile("s_waitcnt vmcnt(0)" ::: "memory"); __hip_atomic_fetch_add((unsigned*)(ws + WS_CTL) + 32, (unsigned)((64 - (int)blockIdx.x + G - 1) / G), __ATOMIC_RELAXED, __HIP_MEMORY_SCOPE_AGENT); }
        }
        unsigned* ctr = (unsigned*)(ws + WS_CTL) + 16; volatile LAS unsigned* qw = (volatile LAS unsigned*)(lds + fa::OFF_Q);
        unsigned nxt_ = 0u; if (tid == 0) nxt_ = atomicAdd(ctr, 1u);
        for (;;) {
            if (tid == 0) qw[0] = nxt_;
            __syncthreads();
            const int it = __builtin_amdgcn_readfirstlane((int)qw[0]);
            __syncthreads();
            if (it >= 1152 + 256 + 1024) break;
            if (tid == 0) nxt_ = atomicAdd(ctr, 1u);
            unsigned* tailcnt = (unsigned*)(ws + WS_CTL) + 32;
            const int it2 = it;
            if (it2 < 1152) fa::attn_item<4>(lds, ws, KA()->in[13], it2, wave_s);
            else if (it2 < 1408) {
                if (((it2 - 1152) >> 4) & 2) {
                    if (tid == 0) { unsigned sp = 0; while (__hip_atomic_load(tailcnt, __ATOMIC_RELAXED, __HIP_MEMORY_SCOPE_AGENT) < 64u && ++sp < (1u << 24)) __builtin_amdgcn_s_sleep(4);
                                    __builtin_amdgcn_fence(__ATOMIC_ACQUIRE, "agent"); asm volatile("s_waitcnt vmcnt(0)" ::: "memory"); }
                    __syncthreads();
                }
                fa::attn_item<5>(lds, ws, KA()->in[13], it2 - 1152, wave_s);
            }
            else fa::attn_item<3>(lds, ws, KA()->in[13], it2 - 1408, wave_s);
        }
    }
    SEAM(6);
    if (IN(7)) {
        PHASE_IDS
        const bf16_t* OP0 = (const bf16_t*)(ws + ws_op(0)); const bf16_t* OP1 = (const bf16_t*)(ws + ws_op(1)); const bf16_t* OP2 = (const bf16_t*)(ws + ws_op(2)); const float* LSE = (const float*)(ws + WS_LSE);
        for (int q = blockIdx.x * 512 + tid; q < T * 96; q += G * 512) {
            const int tok = q / 96, ch = q - tok * 96, hd = ch >> 4;
            const float l0 = LSE[(size_t)tok * 6 + hd], l1 = LSE[((size_t)T + tok) * 6 + hd], l2 = LSE[((size_t)2 * T + tok) * 6 + hd];
            const float mx = fmaxf(l0, fmaxf(l1, l2)); float w0 = __expf(l0 - mx), w1 = __expf(l1 - mx), w2 = __expf(l2 - mx); const float iw = 1.0f / (w0 + w1 + w2); w0 *= iw; w1 *= iw; w2 *= iw;
            const u32x4 a = *(const u32x4*)(OP0 + (size_t)tok * 768 + ch * 8), b = *(const u32x4*)(OP1 + (size_t)tok * 768 + ch * 8), c2 = *(const u32x4*)(OP2 + (size_t)tok * 768 + ch * 8);
            bf16_t* yp = H + (size_t)tok * LDH1 + O_G + 1024 + ch * 8; const u32x4 g = *(const u32x4*)yp; u32x4 w;
#define MIX(aa, bb, cc_, gg) cvt_pk_bf16((w0 * __uint_as_float((aa) << 16) + w1 * __uint_as_float((bb) << 16) + w2 * __uint_as_float((cc_) << 16)) * fa::silu(__uint_as_float((gg) << 16)), \
                (w0 * __uint_as_float((aa) & 0xffff0000u) + w1 * __uint_as_float((bb) & 0xffff0000u) + w2 * __uint_as_float((cc_) & 0xffff0000u)) * fa::silu(__uint_as_float((gg) & 0xffff0000u)))
            w.x = MIX(a.x, b.x, c2.x, g.x); w.y = MIX(a.y, b.y, c2.y, g.y); w.z = MIX(a.z, b.z, c2.z, g.z); w.w = MIX(a.w, b.w, c2.w, g.w);
#undef MIX
            *(u32x4*)yp = w;
        }
    }
    SEAM(7);
    if (IN(8)) {
        if (G == 256 && WGM_OUT == 4) { EpiFinal E{XB, KA()->out, DM, SSQ2, (unsigned*)(ws + WS_CTL) + 8192, KA()->in[17]}; run_gemm(lds, H + O_G, LDH1, WOO, T, DM, 2304, E, 0, wave_s, WGM_OUT); }
        else { EpiRes<true, false> E{XB, nullptr, XB, DM, SSQ2}; run_gemm(lds, H + O_G, LDH1, WOO, T, DM, 2304, E, 0, wave_s, WGM_OUT); }
    }
    if (!(G == 256 && WGM_OUT == 4)) SEAM(8);
    if (IN(9) && !(G == 256 && WGM_OUT == 4)) {
        PHASE_IDS
        const f32x4* gp = (const f32x4*)KA()->in[17] + 2 * lane;
        for (int m = gw; m < T; m += NGW) {
            const float r = 1.0f / sqrtf(SSQ2[m] * (1.0f / DM) + EPS);
            const u32x4* xr = (const u32x4*)(XB + (size_t)m * DM) + lane; f32x4* orow = (f32x4*)(KA()->out + (size_t)m * DM) + 2 * lane;
            u32x4 w[4];
#pragma unroll
            for (int j = 0; j < 4; ++j) w[j] = xr[64 * j];
#pragma unroll
            for (int j = 0; j < 4; ++j) { const f32x4 g0 = gp[128 * j], g1 = gp[128 * j + 1];
                f32x4 v0 = {__uint_as_float(w[j].x << 16), __uint_as_float(w[j].x & 0xffff0000u), __uint_as_float(w[j].y << 16), __uint_as_float(w[j].y & 0xffff0000u)};
                f32x4 v1 = {__uint_as_float(w[j].z << 16), __uint_as_float(w[j].z & 0xffff0000u), __uint_as_float(w[j].w << 16), __uint_as_float(w[j].w & 0xffff0000u)};
                v0 = v0 * r; v0 = v0 * g0; v1 = v1 * r; v1 = v1 * g1; orow[128 * j] = v0; orow[128 * j + 1] = v1; }
        }
    }
#undef KA
#undef PHASE_IDS
#undef IN
#undef SEAM
#undef W1E
#undef WUQ
#undef WUKV
#undef WMKE
#undef WOE
#undef W1O
#undef WMKO
#undef WOO
#undef XB
#undef QA
#undef KVA
#undef H
#undef MEMB
#undef MKVE
#undef MKVO
#undef CS64
#undef CS32
#undef CS16
#undef RS0
#undef SSQQ
#undef SSQKV
#undef SSQ1
#undef SSQ2
#undef RSMEM
#undef KMEAN
}

extern "C" void kernel_launch(void* const* d_in, const int* in_sizes, int n_in, void* d_out, int out_size, void* d_ws, size_t ws_size, hipStream_t stream) {
    static int grid = 0;
    if (grid == 0) {
        if (n_in != 18 || out_size != T * DM || ws_size < WS_END) { fprintf(stderr, "kernel_launch: unexpected shapes (n_in %d out %d ws %zu)\n", n_in, out_size, ws_size); grid = -1; return; }
        int dev = 0, cus = 0, per_cu = 0;
        (void)hipGetDevice(&dev); (void)hipDeviceGetAttribute(&cus, hipDeviceAttributeMultiprocessorCount, dev);
        if (hipFuncSetAttribute((const void*)mega, hipFuncAttributeMaxDynamicSharedMemorySize, LDS_BYTES) != hipSuccess) { fprintf(stderr, "kernel_launch: hipFuncSetAttribute failed\n"); grid = -1; return; }
        (void)hipOccupancyMaxActiveBlocksPerMultiprocessor(&per_cu, (const void*)mega, 512, LDS_BYTES);
        if (per_cu < 1) { fprintf(stderr, "kernel_launch: occupancy query says %d\n", per_cu); per_cu = 1; }
        grid = (cus > 0 ? cus : 256) * 1;
        (void)hipGetLastError();
    }
    if (grid < 0) return;
    (void)hipMemsetAsync((unsigned char*)d_ws + WS_CTL, 0, 65536, stream);
    Args a{};
    for (int i = 0; i < 18; ++i) a.in[i] = (const float*)d_in[i];
    a.out = (float*)d_out; a.ws = (unsigned char*)d_ws;
    a.ph_lo = 0; a.ph_hi = 10;
    void* kargs[] = {&a};
    hipError_t e = hipLaunchCooperativeKernel((const void*)mega, dim3(grid), dim3(512), kargs, LDS_BYTES, stream);
    if (e != hipSuccess) fprintf(stderr, "kernel_launch: cooperative launch failed: %s (grid %d)\n", hipGetErrorString(e), grid);

}
```

```cpp
#include <hip/hip_runtime.h>
#include <hip/hip_cooperative_groups.h>
#include <cstdio>
#include <cstdint>
namespace cg = cooperative_groups;

#ifndef WGM_OUT
#define WGM_OUT 4
#endif
typedef unsigned short bf16_t;
typedef short bf16x8 __attribute__((ext_vector_type(8)));
typedef float f32x4 __attribute__((ext_vector_type(4)));
typedef float f32x2 __attribute__((ext_vector_type(2)));
typedef unsigned u32x4 __attribute__((ext_vector_type(4)));
typedef unsigned u32x2 __attribute__((ext_vector_type(2)));
#define LAS __attribute__((address_space(3)))

constexpr int NB = 4, SEQ = 4096, DM = 2048, T = NB * SEQ, NMEM = 256;
constexpr int LDH0 = 7168, LDH1 = 6400;
constexpr float EPS = 1e-6f;
constexpr int E_CQ = 0, E_CKV = 512, E_KPE = 768, E_QB = 1024, E_KB = 2048, E_VB = 3072, E_QM = 4096, E_G = 4608;
constexpr int O_QC = 0, O_KC = 1024, O_VC = 1152, O_QD = 1280, O_KD = 2048, O_VD = 2816, O_QM = 3584, O_G = 4096;

constexpr size_t MiB = 1u << 20;
constexpr size_t WS_W1E = 0, WS_WUQ = 28 * MiB, WS_WUKV = 30 * MiB, WS_WMKE = 31 * MiB, WS_WOE = 35 * MiB, WS_W1O = 45 * MiB,
                 WS_WMKO = 70 * MiB, WS_WOO = 74 * MiB;
constexpr size_t WS_R1 = 96 * MiB;
constexpr size_t WS_KVA = WS_R1 + 64 * MiB;
constexpr size_t WS_H = 224 * MiB;
constexpr size_t WS_MISC = 448 * MiB;
constexpr size_t WS_MEMB = WS_MISC, WS_MKVE = WS_MISC + 4 * MiB, WS_MKVO = WS_MISC + 6 * MiB;
constexpr size_t WS_CS64 = WS_MISC + 8 * MiB, WS_CS32 = WS_MISC + 9 * MiB, WS_CS16 = WS_MISC + 9 * MiB + 512 * 1024;
constexpr size_t WS_RS0 = WS_MISC + 10 * MiB, WS_SSQQ = WS_RS0 + 65536, WS_SSQKV = WS_RS0 + 2 * 65536, WS_SSQ1 = WS_RS0 + 3 * 65536,
                 WS_SSQ2 = WS_RS0 + 4 * 65536, WS_RSMEM = WS_RS0 + 5 * 65536;
constexpr size_t WS_KMEAN = WS_MISC + 11 * MiB;
constexpr size_t WS_LSE = WS_MISC + 12 * MiB;
constexpr size_t WS_CTL = WS_MISC + 14 * MiB;
constexpr size_t WS_KD = 424 * MiB, WS_VD = 464 * MiB;
constexpr size_t WS_KC = 488 * MiB, WS_VC = 492 * MiB;
constexpr size_t WS_END = 496 * MiB;
__host__ __device__ constexpr size_t ws_op(int p) { return p == 0 ? (size_t)0 : WS_R1 + (size_t)(64 + 24 * (p - 1)) * MiB; }

struct Args { const float* in[18]; float* out; unsigned char* ws; int ph_lo, ph_hi; };

__device__ __forceinline__ int lane_id() { int r = (int)__builtin_amdgcn_mbcnt_hi(~0u, __builtin_amdgcn_mbcnt_lo(~0u, 0u)); asm volatile("" : "+v"(r)); return r; }
template <int MASK> __device__ __forceinline__ float swz_xor(float v) { return __uint_as_float((unsigned)__builtin_amdgcn_ds_swizzle((int)__float_as_uint(v), (MASK << 10) | 0x1F)); }
__device__ __forceinline__ float sum_x32(float v) { auto rr = __builtin_amdgcn_permlane32_swap(__float_as_uint(v), __float_as_uint(v), false, false); return __uint_as_float(rr[0]) + __uint_as_float(rr[1]); }
__device__ __forceinline__ float max_x32(float v) { auto rr = __builtin_amdgcn_permlane32_swap(__float_as_uint(v), __float_as_uint(v), false, false); return fmaxf(__uint_as_float(rr[0]), __uint_as_float(rr[1])); }
__device__ __forceinline__ float xchg_x32(float v) { auto rr = __builtin_amdgcn_permlane32_swap(__float_as_uint(v), __float_as_uint(v), false, false); return __uint_as_float(rr[0] ^ rr[1] ^ __float_as_uint(v)); }
__device__ __forceinline__ float bf2f(bf16_t b) { return __uint_as_float((unsigned)b << 16); }
typedef __bf16 bf16x2_t __attribute__((ext_vector_type(2)));
__device__ __forceinline__ unsigned cvt_pk_bf16(float lo, float hi) { const f32x2 v = {lo, hi}; return __builtin_bit_cast(unsigned, __builtin_convertvector(v, bf16x2_t)); }
__device__ __forceinline__ float wave_sum(float v) {
    v += swz_xor<1>(v); v += swz_xor<2>(v); v += swz_xor<4>(v); v += swz_xor<8>(v); v += swz_xor<16>(v); return sum_x32(v);
}
__device__ __forceinline__ float wave_max(float v) {
    v = fmaxf(v, swz_xor<1>(v)); v = fmaxf(v, swz_xor<2>(v)); v = fmaxf(v, swz_xor<4>(v)); v = fmaxf(v, swz_xor<8>(v)); v = fmaxf(v, swz_xor<16>(v)); return max_x32(v);
}

__device__ __forceinline__ void blockmap(int mat, int db, int& src, int& half) {
    src = 64 * db; half = 0;
    if (mat == 0) {
        if (db < 12) return;
        if (db == 12) { half = 32; return; }
        if (db < 16) { src = -1; return; }
        if (db < 64) { const int j = 64 * db - 1024; src = 832 + j; if ((j >> 10) < 2 && (j & 127) == 0) half = 16; return; }
        if (db < 72) { src = 3904 + (64 * db - 4096); return; }
        src = 4416 + (64 * db - 4608); return;
    }
    if (mat == 1) { if (db % 3 == 2) half = 32; return; }
    if (mat == 5) { if (db < 18) half = 8; else if (db >= 20 && db < 56) { const int j = 64 * db - 1280; if (j / 768 < 2 && (j & 127) == 0) half = 16; } return; }
}
__device__ __forceinline__ void transpose_item(const float* W, int K, int Nsrc, bf16_t* WT, const float* g, int mat, LAS float* scr, int item, int nblk, int lane) {
    const int kb = item / nblk, db = item - kb * nblk, k0 = 64 * kb, n0 = 64 * db;
    int src, half; blockmap(mat, db, src, half);
    const int s4 = 4 * (lane & 15), kr = lane >> 4;
    f32x4 v[16];
    if (src >= 0) {
#pragma unroll
        for (int i = 0; i < 16; ++i) v[i] = __builtin_nontemporal_load((const f32x4*)(W + (size_t)(k0 + kr + 4 * i) * Nsrc + src + s4));
        if (g) {
#pragma unroll
            for (int i = 0; i < 16; ++i) v[i] = v[i] * g[k0 + kr + 4 * i];
        }
    } else {
#pragma unroll
        for (int i = 0; i < 16; ++i) v[i] = (f32x4){0.f, 0.f, 0.f, 0.f};
    }
    int dr[4];
#pragma unroll
    for (int e = 0; e < 4; ++e) { const int sc_ = s4 + e; dr[e] = sc_ < 2 * half ? (sc_ < half ? 2 * sc_ : 2 * (sc_ - half) + 1) : sc_; }
#pragma unroll
    for (int i = 0; i < 16; ++i) { LAS float* rowp = scr + (kr + 4 * i) * 65; rowp[dr[0]] = v[i].x; rowp[dr[1]] = v[i].y; rowp[dr[2]] = v[i].z; rowp[dr[3]] = v[i].w; }
    asm volatile("s_waitcnt lgkmcnt(0)" ::: "memory");
    const int c = lane & 7;
#pragma unroll
    for (int j = 0; j < 8; ++j) { const int n = (lane >> 3) + 8 * j; const LAS float* sp = scr + (8 * c) * 65 + n;
        u32x4 o; o.x = cvt_pk_bf16(sp[0 * 65], sp[1 * 65]); o.y = cvt_pk_bf16(sp[2 * 65], sp[3 * 65]); o.z = cvt_pk_bf16(sp[4 * 65], sp[5 * 65]); o.w = cvt_pk_bf16(sp[6 * 65], sp[7 * 65]);
        *(u32x4*)(WT + (size_t)(n0 + n) * K + k0 + 8 * c) = o; }
    asm volatile("s_waitcnt lgkmcnt(0)" ::: "memory");
}

__device__ __forceinline__ void row_to_bf16(const float* xrow, bf16_t* orow, float* rs, int lane) {
    const f32x4* xr = (const f32x4*)xrow + lane; f32x4 v[8]; float s = 0.f;
#pragma unroll
    for (int j = 0; j < 8; ++j) { v[j] = __builtin_nontemporal_load(xr + 64 * j); s += (v[j].x * v[j].x + v[j].y * v[j].y) + (v[j].z * v[j].z + v[j].w * v[j].w); }
    s = wave_sum(s);
    if (lane == 0) *rs = 1.0f / sqrtf(s * (1.0f / DM) + EPS);
    u32x2* o8 = (u32x2*)orow + lane;
#pragma unroll
    for (int j = 0; j < 8; ++j) { u32x2 w; w.x = cvt_pk_bf16(v[j].x, v[j].y); w.y = cvt_pk_bf16(v[j].z, v[j].w); o8[64 * j] = w; }
}

namespace pg8 {
constexpr int BM = 256, BK = 64, HALF = 128, HTB = HALF * BK * 2, STAGE_BYTES = 8 * HTB, NXCD = 8;
__host__ __device__ __forceinline__ int lds_byte(int r, int c) { const int st = (r >> 4) * 2 + (c >> 5), rr = r & 15, cc = c & 31, ob = rr * 64 + cc * 2; return st * 1024 + (ob ^ (((ob >> 9) & 1) << 5)); }
__host__ __device__ __forceinline__ void stage_rc(int b, int& R, int& C) { const int st = b / 1024, sb = b % 1024, swz = sb ^ (((sb >> 9) & 1) << 5); R = (st >> 1) * 16 + swz / 64; C = (st & 1) * 32 + (swz % 64) / 2; }
__host__ __device__ __forceinline__ int perm32(int rho) { const int n = rho >> 4, i = rho & 15; return 8 * (i >> 2) + 4 * n + (i & 3); }
struct Unit { int pm, pn; };
struct Gemm { const bf16_t* A; const bf16_t* Bt; int M, N, K, lda; };
struct StaticOrder {
    int nM, nN, nwg, G, c, WGM;
    __host__ __device__ void init(int M, int N, int G_, int c_, int wgm_ = 2) { nM = M / BM; nN = N / BM; nwg = nM * nN; G = G_; c = c_; WGM = wgm_; }
    __host__ __device__ void unit_of(int L, Unit& u) const {
        int wgid = L; { const int q = nwg / NXCD, r = nwg % NXCD, xcd = wgid % NXCD, off = wgid / NXCD; wgid = (xcd < r ? xcd * (q + 1) : r * (q + 1) + (xcd - r) * q) + off; }
        const int nig = WGM * nN, gid = wgid / nig, fm = gid * WGM, gsz = (nM - fm) < WGM ? (nM - fm) : WGM;
        u.pm = fm + ((wgid % nig) % gsz); u.pn = (wgid % nig) / gsz;
    }
    __host__ __device__ bool next(int i, Unit& u) const {
        if (c < 0) return false;
        const long L = (long)i * G + c; if (L >= nwg) return false;
        unit_of((int)L, u); return true;
    }
};

template <class Epi, class Sched>
__device__ __forceinline__ void gemm_phase(LAS unsigned char* lds, const Gemm g, const Sched& S, const Epi& E, const int wid) {
    const int lane = lane_id(), tid = wid * 64 + lane, wr = wid >> 2, wc = wid & 3, fr = lane & 15, fq = lane >> 4;
    const int K = g.K, nt = K / BK;
    unsigned voffA[2], voffB[2];
#pragma unroll
    for (int i = 0; i < 2; ++i) { int R, C; stage_rc(tid * 16 + i * 8192, R, C); const int Rb = (R & ~31) + perm32(R & 31); voffA[i] = (unsigned)(R * g.lda + C) * 2u; voffB[i] = (unsigned)(Rb * K + C) * 2u; }
    const size_t kstep = (size_t)(BK * 2);
    const size_t hstepA = (size_t)HALF * g.lda * 2, hstepB = (size_t)HALF * K * 2, tstepA = 2 * hstepA, tstepB = 2 * hstepB;
    const unsigned ldsw = (unsigned)wid * 1024u;
    const int aoff = lds_byte(wr * 64 + fr, fq * 8), boff = lds_byte(wc * 32 + fr, fq * 8);
#define PG8_SA(b, h) (((b) * 2 + (h)) * HTB)
#define PG8_SB(b, h) ((4 + (b) * 2 + (h)) * HTB)
#define PG8_STAGE(bufoff, gbase, voff) do { _Pragma("unroll") for (int _i = 0; _i < 2; ++_i) \
        __builtin_amdgcn_global_load_lds((const unsigned*)((const char*)(gbase) + (voff)[_i]), (LAS unsigned*)(lds + (bufoff) + ldsw + _i * 8192), 16, 0, 0); } while (0)
#define PG8_LDA(dst, b, h) do { _Pragma("unroll") for (int m = 0; m < 4; ++m) _Pragma("unroll") for (int k = 0; k < 2; ++k) dst[m][k] = *(const LAS bf16x8*)(lds + PG8_SA(b, h) + aoff + m * 2048 + k * 1024); } while (0)
#define PG8_LDB(dst, b, h) do { _Pragma("unroll") for (int n = 0; n < 2; ++n) _Pragma("unroll") for (int k = 0; k < 2; ++k) dst[n][k] = *(const LAS bf16x8*)(lds + PG8_SB(b, h) + boff + n * 2048 + k * 1024); } while (0)
#define PG8_MMA(ai, bj, At, Bt) do { __builtin_amdgcn_s_setprio(1); _Pragma("unroll") for (int m = 0; m < 4; ++m) _Pragma("unroll") for (int n = 0; n < 2; ++n) _Pragma("unroll") for (int k = 0; k < 2; ++k) \
        acc[ai][bj][m][n] = __builtin_amdgcn_mfma_f32_16x16x32_bf16(Bt[n][k], At[m][k], acc[ai][bj][m][n], 0, 0, 0); __builtin_amdgcn_s_setprio(0); } while (0)
#define PG8_WAIT_V(n) asm volatile("s_waitcnt vmcnt(" #n ")" ::: "memory")
#define PG8_WAIT_L(n) asm volatile("s_waitcnt lgkmcnt(" #n ")" ::: "memory")
#define PG8_BAR __builtin_amdgcn_s_barrier()
#define PG8_SCHED __builtin_amdgcn_sched_barrier(0)
    Unit cur, nxt; int ui = 0;
    if (!S.next(0, cur)) return;
    f32x4 acc[2][2][4][2];
#pragma unroll
    for (int a = 0; a < 2; ++a)
#pragma unroll
        for (int b = 0; b < 2; ++b)
#pragma unroll
            for (int m = 0; m < 4; ++m)
#pragma unroll
                for (int n = 0; n < 2; ++n) acc[a][b][m][n] = (f32x4){0.f, 0.f, 0.f, 0.f};
    bf16x8 At[4][2], B0[2][2], B1[2][2];
    const char* cA = (const char*)g.A + (size_t)cur.pm * tstepA; const char* cB = (const char*)g.Bt + (size_t)cur.pn * tstepB;
    PG8_STAGE(PG8_SB(0, 0), cB, voffB); PG8_STAGE(PG8_SB(0, 1), cB + hstepB, voffB); PG8_STAGE(PG8_SA(0, 0), cA, voffA); PG8_STAGE(PG8_SA(0, 1), cA + hstepA, voffA);
    if (wr == 1) PG8_BAR;
    PG8_WAIT_V(2); PG8_BAR;
    PG8_STAGE(PG8_SB(1, 0), cB + kstep, voffB); PG8_STAGE(PG8_SA(1, 0), cA + kstep, voffA); PG8_STAGE(PG8_SB(1, 1), cB + hstepB + kstep, voffB);
    PG8_WAIT_V(6); PG8_BAR;
    for (;;) {
        const bool has_next = S.next(ui + 1, nxt);
        const char* nA = has_next ? (const char*)g.A + (size_t)nxt.pm * tstepA : cA; const char* nB = has_next ? (const char*)g.Bt + (size_t)nxt.pn * tstepB : cB;
#pragma unroll 1
        for (int t = 0; t < nt; t += 2) {
            const bool last = (t == nt - 2);
            const char* a1 = cA + (size_t)(t + 1) * kstep;
            const char* a2 = last ? nA : cA + (size_t)(t + 2) * kstep; const char* b2 = last ? nB : cB + (size_t)(t + 2) * kstep;
            const char* a3 = a2 + kstep; const char* b3 = b2 + kstep;
            PG8_LDB(B0, 0, 0); PG8_LDB(B1, 0, 1); PG8_SCHED; PG8_LDA(At, 0, 0); PG8_STAGE(PG8_SA(1, 1), a1 + hstepA, voffA);
            PG8_WAIT_V(8); PG8_WAIT_L(0); PG8_BAR; PG8_MMA(0, 0, At, B0); PG8_MMA(0, 1, At, B1); PG8_BAR; PG8_SCHED;
            PG8_LDA(At, 0, 1); PG8_STAGE(PG8_SB(0, 0), b2, voffB); PG8_STAGE(PG8_SB(0, 1), b2 + hstepB, voffB); PG8_STAGE(PG8_SA(0, 0), a2, voffA);
            PG8_WAIT_V(8); PG8_WAIT_L(0); PG8_BAR; PG8_MMA(1, 0, At, B0); PG8_MMA(1, 1, At, B1); PG8_BAR; PG8_SCHED;
            PG8_LDB(B0, 1, 0); PG8_LDB(B1, 1, 1); PG8_SCHED; PG8_LDA(At, 1, 0); PG8_STAGE(PG8_SA(0, 1), a2 + hstepA, voffA);
            PG8_WAIT_V(8); PG8_WAIT_L(0); PG8_BAR; PG8_MMA(0, 0, At, B0); PG8_MMA(0, 1, At, B1); PG8_BAR; PG8_SCHED;
            PG8_LDA(At, 1, 1); PG8_STAGE(PG8_SB(1, 0), b3, voffB); PG8_STAGE(PG8_SB(1, 1), b3 + hstepB, voffB); PG8_STAGE(PG8_SA(1, 0), a3, voffA);
            PG8_WAIT_V(8); PG8_WAIT_L(0); PG8_BAR; PG8_MMA(1, 0, At, B0); PG8_MMA(1, 1, At, B1); PG8_BAR; PG8_SCHED;
        }
        if (wr == 0) PG8_BAR;
        E(acc, cur, wr, wc, fr, fq);
        if (!has_next) break;
#pragma unroll
        for (int a = 0; a < 2; ++a)
#pragma unroll
            for (int b = 0; b < 2; ++b)
#pragma unroll
                for (int m = 0; m < 4; ++m)
#pragma unroll
                    for (int n = 0; n < 2; ++n) acc[a][b][m][n] = (f32x4){0.f, 0.f, 0.f, 0.f};
        cur = nxt; cA = nA; cB = nB; ++ui;
        if (wr == 1) PG8_BAR;
    }
    PG8_WAIT_V(0);
    PG8_BAR;
#undef PG8_SA
#undef PG8_SB
#undef PG8_STAGE
#undef PG8_LDA
#undef PG8_LDB
#undef PG8_MMA
#undef PG8_WAIT_V
#undef PG8_WAIT_L
#undef PG8_BAR
#undef PG8_SCHED
}
}

template <int MODE> struct EpiBF {
    bf16_t* O; int ldc; const float* rs; const float* ssq_in; float inv_n; float* ssq_a; float* ssq_b;
    const f32x2* cs64; const f32x2* cs32; const f32x2* cs16;
    __device__ __forceinline__ void operator()(const f32x4 (&acc)[2][2][4][2], const pg8::Unit& u, int wr, int wc, int fr, int fq) const {
        asm volatile("" : "+v"(fr), "+v"(fq));
        const int row0 = u.pm * 256 + wr * 64 + fr;
        float sc[2][4];
#pragma unroll
        for (int ai = 0; ai < 2; ++ai)
#pragma unroll
            for (int m = 0; m < 4; ++m) sc[ai][m] = (MODE == 1 || MODE == 2 || MODE == 3) ? ssq_in[row0 + ai * 128 + m * 16] : rs[row0 + ai * 128 + m * 16];
        if (MODE == 1 || MODE == 2 || MODE == 3) {
#pragma unroll
            for (int ai = 0; ai < 2; ++ai)
#pragma unroll
                for (int m = 0; m < 4; ++m) sc[ai][m] = 1.0f / sqrtf(sc[ai][m] * inv_n + EPS);
        }
        float ss[2][4] = {{0.f, 0.f, 0.f, 0.f}, {0.f, 0.f, 0.f, 0.f}};
        const bool do_ss = (MODE == 0) && u.pn < 3 && ssq_a != nullptr;
        const bool gate_tile = (MODE == 0 && (u.pn >= 16 || (u.pn >= 4 && u.pn < 8))) || (MODE == 3 && (u.pn >= 14 || u.pn < 4 || (u.pn >= 5 && u.pn < 8)));
#pragma unroll
        for (int bj = 0; bj < 2; ++bj) {
            const int colb = u.pn * 256 + bj * 128 + wc * 32, col = colb + 8 * fq;
            bf16_t* dst = O; int dld = ldc, dcol = col;
            if (MODE == 3) {
                unsigned char* wsb = (unsigned char*)O - WS_H;
                if (u.pn == 4) { dst = (bf16_t*)(wsb + (bj == 0 ? WS_KC : WS_VC)) + (size_t)(wc >> 1) * T * 64; dld = 64; dcol = (wc & 1) * 32 + 8 * fq; }
                else if (u.pn >= 8 && u.pn < 14) { const int hd = u.pn * 2 + bj - (u.pn < 11 ? 16 : 22); dst = (bf16_t*)(wsb + (u.pn < 11 ? WS_KD : WS_VD)) + (size_t)hd * T * 128; dld = 128; dcol = wc * 32 + 8 * fq; }
            }
            const f32x2* tb = nullptr; int nf = 0, i0 = 4 * fq; bool lrope = true;
            if (MODE == 0) {
                if (u.pn == 3 && bj == 0 && wc < 2) { tb = cs64; nf = 32; i0 = wc * 16 + 4 * fq; }
                else if (u.pn >= 4 && u.pn < 12 && wc == 0) { tb = cs32; nf = 16; }
            } else if (MODE == 1) {
                const int d = colb % 192; if (d >= 128) { tb = cs64; nf = 32; i0 = ((d - 128) >> 1) + 4 * fq; }
            } else if (MODE == 3) {
                if ((u.pn < 4 || (u.pn == 4 && bj == 0)) && (wc & 1) == 0) { tb = cs16; nf = 8; lrope = fq < 2; if (!lrope) i0 = 0; }
                else if (u.pn >= 5 && u.pn < 11 && wc == 0) { tb = cs32; nf = 16; }
            }
            if (tb != nullptr) {
#pragma unroll
                for (int h4 = 0; h4 < 4; ++h4) {
                    const int ai = h4 >> 1, mb = (h4 & 1) * 2;
                    f32x4 t0[2], t1[2];
#pragma unroll
                    for (int mm = 0; mm < 2; ++mm) { const int pos = (row0 + ai * 128 + (mb + mm) * 16) & (SEQ - 1); const f32x4* tp = (const f32x4*)(tb + pos * nf + i0); t0[mm] = tp[0]; t1[mm] = tp[1]; }
#pragma unroll
                    for (int mm = 0; mm < 2; ++mm) { const int m = mb + mm;
                        const f32x4 v0 = acc[ai][bj][m][0] * sc[ai][m], v1 = acc[ai][bj][m][1] * sc[ai][m]; const f32x4 a = t0[mm], b = t1[mm];
                        f32x4 r0, r1;
                        r0.x = v0.x * a.x - v0.y * a.y; r0.y = v0.x * a.y + v0.y * a.x; r0.z = v0.z * a.z - v0.w * a.w; r0.w = v0.z * a.w + v0.w * a.z;
                        r1.x = v1.x * b.x - v1.y * b.y; r1.y = v1.x * b.y + v1.y * b.x; r1.z = v1.z * b.z - v1.w * b.w; r1.w = v1.z * b.w + v1.w * b.z;
                        if (!lrope) { r0 = v0; r1 = v1; }
                        u32x4 w; w.x = cvt_pk_bf16(r0.x, r0.y); w.y = cvt_pk_bf16(r0.z, r0.w); w.z = cvt_pk_bf16(r1.x, r1.y); w.w = cvt_pk_bf16(r1.z, r1.w);
                        if (gate_tile) __builtin_nontemporal_store(w, (u32x4*)(dst + (size_t)(row0 + ai * 128 + m * 16) * dld + dcol));
                        else *(u32x4*)(dst + (size_t)(row0 + ai * 128 + m * 16) * dld + dcol) = w;
                    }
                }
            } else {
#pragma unroll
                for (int ai = 0; ai < 2; ++ai)
#pragma unroll
                    for (int m = 0; m < 4; ++m) {
                        const f32x4 v0 = acc[ai][bj][m][0] * sc[ai][m], v1 = acc[ai][bj][m][1] * sc[ai][m];
                        if (MODE == 0) ss[ai][m] += ((v0.x * v0.x + v0.y * v0.y) + (v0.z * v0.z + v0.w * v0.w)) + ((v1.x * v1.x + v1.y * v1.y) + (v1.z * v1.z + v1.w * v1.w));
                        u32x4 w; w.x = cvt_pk_bf16(v0.x, v0.y); w.y = cvt_pk_bf16(v0.z, v0.w); w.z = cvt_pk_bf16(v1.x, v1.y); w.w = cvt_pk_bf16(v1.z, v1.w);
                        if (gate_tile) __builtin_nontemporal_store(w, (u32x4*)(dst + (size_t)(row0 + ai * 128 + m * 16) * dld + dcol));
                        else *(u32x4*)(dst + (size_t)(row0 + ai * 128 + m * 16) * dld + dcol) = w;
                    }
            }
        }
        if (do_ss) {
            float* dst = u.pn < 2 ? ssq_a : ssq_b;
#pragma unroll
            for (int ai = 0; ai < 2; ++ai)
#pragma unroll
                for (int m = 0; m < 4; ++m) { float t = ss[ai][m]; t += swz_xor<16>(t); t = sum_x32(t); if (fq == 0) atomicAdd(dst + row0 + ai * 128 + m * 16, t); }
        }
    }
};
template <bool BB, bool WF> struct EpiRes {
    const void* base; float* out; bf16_t* ob; int ldc; float* ssq;
    __device__ __forceinline__ void operator()(const f32x4 (&acc)[2][2][4][2], const pg8::Unit& u, int wr, int wc, int fr, int fq) const {
        asm volatile("" : "+v"(fr), "+v"(fq));
        const int row0 = u.pm * 256 + wr * 64 + fr, col0 = u.pn * 256 + wc * 32 + 8 * fq;
#pragma unroll
        for (int h2 = 0; h2 < 4; ++h2) {
            const int ai = h2 >> 1, mb = (h2 & 1) * 2;
            f32x4 pre[2][2][2];
#pragma unroll
            for (int mm = 0; mm < 2; ++mm)
#pragma unroll
                for (int bj = 0; bj < 2; ++bj) {
                    const size_t off = (size_t)(row0 + ai * 128 + (mb + mm) * 16) * ldc + col0 + bj * 128;
                    if (BB) { const u32x4 w = *(const u32x4*)((const bf16_t*)base + off);
                        pre[mm][bj][0] = (f32x4){__uint_as_float(w.x << 16), __uint_as_float(w.x & 0xffff0000u), __uint_as_float(w.y << 16), __uint_as_float(w.y & 0xffff0000u)};
                        pre[mm][bj][1] = (f32x4){__uint_as_float(w.z << 16), __uint_as_float(w.z & 0xffff0000u), __uint_as_float(w.w << 16), __uint_as_float(w.w & 0xffff0000u)}; }
                    else { const float* p = (const float*)base + off; pre[mm][bj][0] = *(const f32x4*)p; pre[mm][bj][1] = *(const f32x4*)(p + 4); } }
#pragma unroll
            for (int mm = 0; mm < 2; ++mm) {
                const int m = mb + mm, row = row0 + ai * 128 + m * 16; float ss = 0.f;
#pragma unroll
                for (int bj = 0; bj < 2; ++bj) {
                    const size_t off = (size_t)row * ldc + col0 + bj * 128;
                    const f32x4 o0 = pre[mm][bj][0] + acc[ai][bj][m][0], o1 = pre[mm][bj][1] + acc[ai][bj][m][1];
                    if (WF) { *(f32x4*)(out + off) = o0; *(f32x4*)(out + off + 4) = o1; }
                    ss += ((o0.x * o0.x + o0.y * o0.y) + (o0.z * o0.z + o0.w * o0.w)) + ((o1.x * o1.x + o1.y * o1.y) + (o1.z * o1.z + o1.w * o1.w));
                    if (ob) { u32x4 w; w.x = cvt_pk_bf16(o0.x, o0.y); w.y = cvt_pk_bf16(o0.z, o0.w); w.z = cvt_pk_bf16(o1.x, o1.y); w.w = cvt_pk_bf16(o1.z, o1.w); *(u32x4*)(ob + off) = w; }
                }
                if (ssq) { ss += swz_xor<16>(ss); ss = sum_x32(ss); if (fq == 0) atomicAdd(ssq + row, ss); }
            }
        }
    }
};

struct EpiFinal {
    const bf16_t* base; float* out; int ldc; float* ssq; unsigned* cnt; const float* g;
    __device__ __forceinline__ void operator()(f32x4 (&acc)[2][2][4][2], const pg8::Unit& u, int wr, int wc, int fr, int fq) const {
        asm volatile("" : "+v"(fr), "+v"(fq));
        const int row0 = u.pm * 256 + wr * 64 + fr, col0 = u.pn * 256 + wc * 32 + 8 * fq;
#pragma unroll
        for (int h2 = 0; h2 < 4; ++h2) {
            const int ai = h2 >> 1, mb = (h2 & 1) * 2;
            u32x4 pre[2][2];
#pragma unroll
            for (int mm = 0; mm < 2; ++mm)
#pragma unroll
                for (int bj = 0; bj < 2; ++bj) pre[mm][bj] = *(const u32x4*)(base + (size_t)(row0 + ai * 128 + (mb + mm) * 16) * ldc + col0 + bj * 128);
#pragma unroll
            for (int mm = 0; mm < 2; ++mm) {
                const int m = mb + mm, row = row0 + ai * 128 + m * 16; float ss = 0.f;
#pragma unroll
                for (int bj = 0; bj < 2; ++bj) {
                    const u32x4 w = pre[mm][bj];
                    const f32x4 o0 = (f32x4){__uint_as_float(w.x << 16), __uint_as_float(w.x & 0xffff0000u), __uint_as_float(w.y << 16), __uint_as_float(w.y & 0xffff0000u)} + acc[ai][bj][m][0];
                    const f32x4 o1 = (f32x4){__uint_as_float(w.z << 16), __uint_as_float(w.z & 0xffff0000u), __uint_as_float(w.w << 16), __uint_as_float(w.w & 0xffff0000u)} + acc[ai][bj][m][1];
                    acc[ai][bj][m][0] = o0; acc[ai][bj][m][1] = o1;
                    ss += ((o0.x * o0.x + o0.y * o0.y) + (o0.z * o0.z + o0.w * o0.w)) + ((o1.x * o1.x + o1.y * o1.y) + (o1.z * o1.z + o1.w * o1.w));
                }
                ss += swz_xor<16>(ss); ss = sum_x32(ss); if (fq == 0) atomicAdd(ssq + row, ss);
            }
        }
        asm volatile("s_waitcnt vmcnt(0)" ::: "memory");
        __builtin_amdgcn_s_barrier();
        if (wr == 0 && wc == 0) {
            unsigned* cw = cnt + 64 * u.pm;
            if (fr == 0 && fq == 0) __hip_atomic_fetch_add(cw, 1u, __ATOMIC_RELAXED, __HIP_MEMORY_SCOPE_AGENT);
            unsigned sp = 0; while (__hip_atomic_load(cw, __ATOMIC_RELAXED, __HIP_MEMORY_SCOPE_AGENT) < 8u && ++sp < (1u << 22)) __builtin_amdgcn_s_sleep(2);
        }
        __builtin_amdgcn_s_barrier();
        float rsv[2][4];
#pragma unroll
        for (int ai = 0; ai < 2; ++ai)
#pragma unroll
            for (int m = 0; m < 4; ++m) rsv[ai][m] = __hip_atomic_load(ssq + row0 + ai * 128 + m * 16, __ATOMIC_RELAXED, __HIP_MEMORY_SCOPE_AGENT);
#pragma unroll
        for (int ai = 0; ai < 2; ++ai)
#pragma unroll
            for (int m = 0; m < 4; ++m) rsv[ai][m] = 1.0f / sqrtf(rsv[ai][m] * (1.0f / DM) + EPS);
#pragma unroll
        for (int bj = 0; bj < 2; ++bj) {
            const f32x4 g0 = *(const f32x4*)(g + col0 + bj * 128), g1 = *(const f32x4*)(g + col0 + bj * 128 + 4);
#pragma unroll
            for (int ai = 0; ai < 2; ++ai)
#pragma unroll
                for (int m = 0; m < 4; ++m) {
                    const size_t off = (size_t)(row0 + ai * 128 + m * 16) * ldc + col0 + bj * 128; const float r = rsv[ai][m];
                    *(f32x4*)(out + off) = acc[ai][bj][m][0] * r * g0; *(f32x4*)(out + off + 4) = acc[ai][bj][m][1] * r * g1;
                }
        }
    }
};

struct TailUnits { int c, G, n, pn; __device__ __forceinline__ bool next(int i, pg8::Unit& u) const { const int pm = c + i * G; if (pm >= n) return false; u.pm = pm; u.pn = pn; return true; } };
template <class Epi, class Sched>
__device__ __forceinline__ void run_gemm_s(LAS unsigned char* lds, const bf16_t* A, int lda, const bf16_t* Bt, int M, int N, int K, const Epi& E, const Sched& S, const int wave_s) {
    pg8::Gemm g{A, Bt, M, N, K, lda};
    pg8::gemm_phase<Epi, Sched>(lds, g, S, E, wave_s);
}
template <class Epi>
__device__ __forceinline__ void run_gemm(LAS unsigned char* lds, const bf16_t* A, int lda, const bf16_t* Bt, int M, int N, int K, const Epi& E, int coff, const int wave_s, const int wgm = 2) {
    pg8::Gemm g{A, Bt, M, N, K, lda}; pg8::StaticOrder S; int cc_ = (int)blockIdx.x + coff; if (cc_ >= (int)gridDim.x) cc_ -= (int)gridDim.x; S.init(M, N, (int)gridDim.x, cc_, wgm);
    pg8::gemm_phase<Epi, pg8::StaticOrder>(lds, g, S, E, wave_s);
}

namespace fa {
typedef float f32x16 __attribute__((ext_vector_type(16)));
typedef short s16x4 __attribute__((ext_vector_type(4)));
constexpr int KMAXB = 24576, VMAXB = 16384;
constexpr int OFF_V = 3 * KMAXB, OFF_SCR = OFF_V + 2 * VMAXB, OFF_STG = 0, OFF_Q = OFF_SCR + 8 * 256, LDS_NEED = OFF_Q + 16;
constexpr float THR = 8.f;
__device__ __forceinline__ s16x4 vtr(const LAS unsigned char* p) { return __builtin_bit_cast(s16x4, __builtin_amdgcn_ds_read_tr16_b64_v4i16((LAS s16x4*)p)); }
__device__ __forceinline__ float silu(float g) { return g * __builtin_amdgcn_rcpf(1.0f + __builtin_amdgcn_exp2f(-1.4426950408889634f * g)); }

template <int MODE>
__device__ __forceinline__ void attn_item(LAS unsigned char* lds, unsigned char* ws, const float* sinks, int item, const int wave) {
    constexpr int DQK = MODE == 0 ? 192 : MODE == 3 ? 64 : 128, DV = MODE == 3 ? 64 : 128;
    constexpr int NKC = DQK / 64, NVC = DV / 64, ND0 = DQK / 16, NDV = DV / 32;
    constexpr int LDH = (MODE <= 2) ? LDH0 : LDH1;
    constexpr bool CAUSAL = (MODE == 0 || MODE == 1), NOMASK = (MODE == 2 || MODE == 5);
    constexpr unsigned WD = CAUSAL ? 0x7fffffffu : (MODE == 3 ? 127u : 128u);
    constexpr float SCALE = MODE == 0 ? 0.07216878364870322f : MODE == 3 ? 0.125f : 0.08838834764831845f;
    constexpr float C2 = SCALE * 1.4426950408889634f;
    int tid = wave * 64 + lane_id(); asm volatile("" : "+v"(tid));
    const int lane = tid & 63, c = lane & 31, hi = lane >> 5;
    bf16_t* H = (bf16_t*)(ws + WS_H);
    const bf16_t* qrow; const bf16_t* kbase; const bf16_t* k2base = nullptr; const bf16_t* vbase; long kstride, vstride, k2stride = 0;
    int qpos, kt_first, nt, blk = 0; long tok0, tokstep = 1; int ycol = 0, hh, pat = 0;
    if (MODE == 0 || MODE == 1) {
        const int qt = 15 - (item >> 5), bh = item & 31, b = bh >> 3; hh = bh & 7; blk = qt;
        tok0 = (long)b * SEQ + 256 * qt + 32 * wave; qpos = 256 * qt + 32 * wave; kt_first = 0; nt = 4 * (qt + 1);
        if (MODE == 0) {
            qrow = (const bf16_t*)sinks + (tok0 + c) * 1536 + hh * 192;
            kbase = (const bf16_t*)(ws + WS_KVA) + (long)b * SEQ * 2048 + hh * 256; kstride = 2048; vbase = kbase + 128; vstride = 2048;
            k2base = H + (long)b * SEQ * LDH0 + E_KPE; k2stride = LDH0; ycol = E_G + hh * 128;
        } else {
            qrow = H + (tok0 + c) * LDH0 + E_QB + hh * 128; kbase = H + (long)b * SEQ * LDH0 + E_KB + hh * 128; vbase = H + (long)b * SEQ * LDH0 + E_VB + hh * 128;
            kstride = vstride = LDH0; ycol = E_G + 1024 + hh * 128;
        }
    } else if (MODE == 2 || MODE == 5) {
        const int b = item >> 6, qt = item & 15; hh = (item >> 4) & 3;
        tok0 = (long)b * SEQ + 256 * qt + 32 * wave; qpos = 0; kt_first = 0; nt = 4;
        const bf16_t* MKV = (const bf16_t*)(ws + (MODE == 2 ? WS_MKVE : WS_MKVO));
        qrow = H + (tok0 + c) * LDH + (MODE == 2 ? E_QM : O_QM) + hh * 128;
        kbase = MKV + (long)b * NMEM * 1024 + hh * 128; vbase = kbase + 512; kstride = vstride = 1024;
        ycol = (MODE == 2 ? E_G + 2048 : O_G + 1792) + hh * 128;
    } else if (MODE == 3) {
        const int b = item >> 8, kvh = (item >> 7) & 1, tt = item & 127, t0 = 32 * tt; hh = kvh * 8 + wave;
        tok0 = (long)b * SEQ + t0; qpos = t0; kt_first = (t0 > 127 ? t0 - 127 : 0) & ~63; nt = ((t0 + 31) >> 6) - (kt_first >> 6) + 1;
        qrow = H + (tok0 + c) * LDH1 + O_QC + hh * 64; kbase = (const bf16_t*)(ws + WS_KC) + ((long)kvh * T + (long)b * SEQ) * 64; vbase = (const bf16_t*)(ws + WS_VC) + ((long)kvh * T + (long)b * SEQ) * 64;
        kstride = vstride = 64; ycol = O_G + hh * 64;
    } else {
        pat = item / 384; const int jj = item - pat * 384; hh = jj % 6; const int rest = jj / 6, b = rest >> 4;
        int r, qt, d;
        if (pat == 0) { r = 0; qt = rest & 15; d = 1; } else if (pat == 1) { r = (rest >> 2) & 3; qt = rest & 3; d = 4; } else { r = rest & 15; qt = 0; d = 16; }
        const long base = (long)b * SEQ + r; qpos = 256 * qt + 32 * wave; tokstep = d; tok0 = base + (long)d * qpos;
        kt_first = qt > 0 ? 256 * qt - 128 : 0; nt = 4 * (qt + 1) - (kt_first >> 6);
        qrow = H + (tok0 + (long)d * c) * LDH1 + O_QD + hh * 128; kbase = (const bf16_t*)(ws + WS_KD) + ((long)hh * T + base) * 128; vbase = (const bf16_t*)(ws + WS_VD) + ((long)hh * T + base) * 128;
        kstride = vstride = (long)d * 128;
    }
    bf16x8 qf[ND0];
#pragma unroll
    for (int d0 = 0; d0 < ND0; ++d0) qf[d0] = *(const bf16x8*)(qrow + 16 * d0 + 8 * hi);
    unsigned selmask = 0;
    if (MODE == 1 && blk > 0) {
        const float* km = (const float*)(ws + WS_KMEAN) + ((size_t)((item & 31) * 16 + (c & 15))) * 128;
        f32x16 G = {0.f, 0.f, 0.f, 0.f, 0.f, 0.f, 0.f, 0.f, 0.f, 0.f, 0.f, 0.f, 0.f, 0.f, 0.f, 0.f};
#pragma unroll
        for (int d0 = 0; d0 < 8; ++d0) {
            f32x4 a = *(const f32x4*)(km + 16 * d0 + 8 * hi), b = *(const f32x4*)(km + 16 * d0 + 8 * hi + 4);
            if (c >= 16) { a = (f32x4){0.f, 0.f, 0.f, 0.f}; b = a; }
            u32x4 wh; wh.x = cvt_pk_bf16(a.x, a.y); wh.y = cvt_pk_bf16(a.z, a.w); wh.z = cvt_pk_bf16(b.x, b.y); wh.w = cvt_pk_bf16(b.z, b.w);
            f32x4 ra, rb;
            ra.x = a.x - __uint_as_float(wh.x << 16); ra.y = a.y - __uint_as_float(wh.x & 0xffff0000u); ra.z = a.z - __uint_as_float(wh.y << 16); ra.w = a.w - __uint_as_float(wh.y & 0xffff0000u);
            rb.x = b.x - __uint_as_float(wh.z << 16); rb.y = b.y - __uint_as_float(wh.z & 0xffff0000u); rb.z = b.z - __uint_as_float(wh.w << 16); rb.w = b.w - __uint_as_float(wh.w & 0xffff0000u);
            u32x4 wl; wl.x = cvt_pk_bf16(ra.x, ra.y); wl.y = cvt_pk_bf16(ra.z, ra.w); wl.z = cvt_pk_bf16(rb.x, rb.y); wl.w = cvt_pk_bf16(rb.z, rb.w);
            G = __builtin_amdgcn_mfma_f32_32x32x16_bf16(__builtin_bit_cast(bf16x8, wh), qf[d0], G, 0, 0, 0);
            G = __builtin_amdgcn_mfma_f32_32x32x16_bf16(__builtin_bit_cast(bf16x8, wl), qf[d0], G, 0, 0, 0);
        }
        float gv[16];
#pragma unroll
        for (int r = 0; r < 8; ++r) { const float own = G[r], oth = xchg_x32(own); const int n0 = (r & 3) + 8 * (r >> 2);
            gv[n0] = hi == 0 ? own : oth; gv[n0 + 4] = hi == 0 ? oth : own; }
        unsigned used = 0;
#pragma unroll
        for (int k = 0; k < 3; ++k) { int best = -1; float bv = -INFINITY;
#pragma unroll
            for (int n = 0; n < 16; ++n) if (!((used >> n) & 1u) && n < blk && (best < 0 || gv[n] > bv)) { best = n; bv = gv[n]; }
            if (best >= 0) used |= 1u << best; }
        selmask = used;
    }
    LAS unsigned char* scrb = lds + OFF_SCR + wave * 256; LAS float* al = (LAS float*)scrb; LAS float* li = al + 32; const LAS float* alh = al + 4 * hi; const LAS float* lih = li + 4 * hi;
    const int kk = wave * 8 + (lane & 7), cc = lane >> 3;
    const int kwr = cc * 1024 + kk * 16;
    int kvr, vwr; long vgo;
    if (DV == 128) { kvr = tid >> 4; const int c16 = tid & 15; vwr = kvr * 256 + ((((c16 >> 2) ^ (kvr & 3))) << 6) + (c16 & 3) * 16; vgo = 8 * c16; }
    else { kvr = tid >> 3; const int c8 = tid & 7; vwr = kvr * 128 + ((((c8 >> 2) ^ ((kvr >> 1) & 1))) << 6) + (c8 & 3) * 16; vgo = 8 * c8; }
    const int krd = hi * 1024 + c * 16;
    const int q4 = (lane & 15) >> 2, p4 = lane & 3, colhalf = (lane >> 4) & 1;
    int vrd, vq[NDV];
    if (DV == 128) { vrd = (4 * hi + q4) * 256 + 32 * colhalf + 8 * p4;
#pragma unroll
        for (int d0 = 0; d0 < NDV; ++d0) vq[d0] = (d0 ^ q4) << 6; }
    else { vrd = (4 * hi + q4) * 128 + 32 * colhalf + 8 * p4;
#pragma unroll
        for (int d0 = 0; d0 < NDV; ++d0) vq[d0] = (d0 ^ ((q4 >> 1) & 1)) << 6; }
    constexpr int VS = DV * 2 * 16, VH = DV * 2 * 8;
    u32x4 kst[NKC], vst[NVC];
    f32x16 o[NDV];
#pragma unroll
    for (int d0 = 0; d0 < NDV; ++d0) o[d0] = (f32x16){0.f, 0.f, 0.f, 0.f, 0.f, 0.f, 0.f, 0.f, 0.f, 0.f, 0.f, 0.f, 0.f, 0.f, 0.f, 0.f};
    float m_reg = -1e30f, l_reg = 0.f;
    constexpr bool SKIPMODE = (MODE == 3 || MODE == 4);
    if constexpr (SKIPMODE) {
#define FA_GLOAD(t) do { const long j0_ = kt_first + 64 * (t); \
        _Pragma("unroll") for (int i_ = 0; i_ < NKC; ++i_) { \
            if (MODE == 0 && i_ == 2) kst[i_] = *(const u32x4*)(k2base + (j0_ + kk) * k2stride + 8 * cc); \
            else kst[i_] = *(const u32x4*)(kbase + (j0_ + kk) * kstride + 8 * (8 * i_ + cc)); } \
        _Pragma("unroll") for (int i_ = 0; i_ < NVC; ++i_) vst[i_] = *(const u32x4*)(vbase + (j0_ + kvr + 32 * i_) * vstride + vgo); } while (0)
#define FA_LWRITE(bf) do { LAS unsigned char* kb_ = lds + (bf) * KMAXB; LAS unsigned char* vb_ = lds + OFF_V + (bf) * VMAXB; \
        _Pragma("unroll") for (int i_ = 0; i_ < NKC; ++i_) *(LAS u32x4*)(kb_ + kwr + i_ * 8192) = kst[i_]; \
        _Pragma("unroll") for (int i_ = 0; i_ < NVC; ++i_) *(LAS u32x4*)(vb_ + vwr + i_ * 8192) = vst[i_]; } while (0)
    FA_GLOAD(0); FA_LWRITE(0);
    __syncthreads();
    for (int t = 0; t < nt; ++t) {
        const int kt0 = kt_first + 64 * t;
        if (t + 1 < nt) FA_GLOAD(t + 1);
        bool act = true, rowmask = false, bandmask = false;
        if (MODE == 1 && t < 4 * blk) { const int n = t >> 2; const bool mine = (selmask >> n) & 1u; act = __ballot(mine) != 0ull; rowmask = true; }
        else if (!NOMASK) {
            act = kt0 <= qpos + 31 && (CAUSAL || kt0 + 63 + (int)WD >= qpos);
            bandmask = !(kt0 + 63 <= qpos && (CAUSAL || kt0 + (int)WD >= qpos + 31));
        }
        if (act) {
            LAS unsigned char* kb = lds + (t & 1) * KMAXB; LAS unsigned char* vb = lds + OFF_V + (t & 1) * VMAXB;
            f32x16 p0 = {0.f, 0.f, 0.f, 0.f, 0.f, 0.f, 0.f, 0.f, 0.f, 0.f, 0.f, 0.f, 0.f, 0.f, 0.f, 0.f}, p1 = p0;
            {
                bf16x8 k0[ND0], k1[ND0];
#pragma unroll
                for (int d0 = 0; d0 < ND0; ++d0) { k0[d0] = *(const LAS bf16x8*)(kb + krd + d0 * 2048); k1[d0] = *(const LAS bf16x8*)(kb + krd + d0 * 2048 + 512); }
#pragma unroll
                for (int d0 = 0; d0 < ND0; ++d0) { p0 = __builtin_amdgcn_mfma_f32_32x32x16_bf16(k0[d0], qf[d0], p0, 0, 0, 0); p1 = __builtin_amdgcn_mfma_f32_32x32x16_bf16(k1[d0], qf[d0], p1, 0, 0, 0); }
                __builtin_amdgcn_sched_group_barrier(0x100, 4, 0);
#pragma unroll
                for (int d0 = 0; d0 < ND0; ++d0) { if (d0 + 2 < ND0) __builtin_amdgcn_sched_group_barrier(0x100, 2, 0); __builtin_amdgcn_sched_group_barrier(0x008, 2, 0); }
            }
            if (rowmask) { if (!((selmask >> (t >> 2)) & 1u)) {
#pragma unroll
                for (int r = 0; r < 16; ++r) { p0[r] = -INFINITY; p1[r] = -INFINITY; } } }
            if (bandmask) { const int dq = qpos + c - kt0 - 4 * hi;
#pragma unroll
                for (int r = 0; r < 16; ++r) { const int cr = (r & 3) + 8 * (r >> 2);
                    if ((unsigned)(dq - cr) > WD) p0[r] = -INFINITY;
                    if ((unsigned)(dq - cr - 32) > WD) p1[r] = -INFINITY; } }
            float pmax = p0[0];
#pragma unroll
            for (int r = 1; r < 16; ++r) pmax = fmaxf(pmax, p0[r]);
#pragma unroll
            for (int r = 0; r < 16; ++r) pmax = fmaxf(pmax, p1[r]);
            pmax = max_x32(pmax);
            if (!__all((pmax - m_reg) * SCALE <= THR)) {
                const float mn = fmaxf(m_reg, pmax), alpha = __builtin_amdgcn_exp2f((m_reg - mn) * C2); m_reg = mn; l_reg *= alpha;
                if (hi == 0) al[c] = alpha;
                asm volatile("s_waitcnt lgkmcnt(0)" ::: "memory");
#pragma unroll
                for (int r = 0; r < 16; ++r) { const float f = alh[(r & 3) + 8 * (r >> 2)];
#pragma unroll
                    for (int d0 = 0; d0 < NDV; ++d0) o[d0][r] *= f; }
                asm volatile("s_waitcnt lgkmcnt(0)" ::: "memory");
            }
            const float mnl = -m_reg * C2; float ps = 0.f;
#pragma unroll
            for (int r = 0; r < 16; ++r) { p0[r] = __builtin_amdgcn_exp2f(fmaf(p0[r], C2, mnl)); p1[r] = __builtin_amdgcn_exp2f(fmaf(p1[r], C2, mnl)); ps += p0[r] + p1[r]; }
            l_reg += ps;
            bf16x8 pa[4];
#pragma unroll
            for (int s = 0; s < 4; ++s) { u32x4 w;
                if (s < 2) { w.x = cvt_pk_bf16(p0[8 * s + 0], p0[8 * s + 1]); w.y = cvt_pk_bf16(p0[8 * s + 2], p0[8 * s + 3]); w.z = cvt_pk_bf16(p0[8 * s + 4], p0[8 * s + 5]); w.w = cvt_pk_bf16(p0[8 * s + 6], p0[8 * s + 7]); }
                else { const int s2 = s - 2; w.x = cvt_pk_bf16(p1[8 * s2 + 0], p1[8 * s2 + 1]); w.y = cvt_pk_bf16(p1[8 * s2 + 2], p1[8 * s2 + 3]); w.z = cvt_pk_bf16(p1[8 * s2 + 4], p1[8 * s2 + 5]); w.w = cvt_pk_bf16(p1[8 * s2 + 6], p1[8 * s2 + 7]); }
                pa[s] = __builtin_bit_cast(bf16x8, w); }
            {
                s16x4 lo[4 * NDV], hv[4 * NDV];
#pragma unroll
                for (int s = 0; s < 4; ++s)
#pragma unroll
                    for (int d0 = 0; d0 < NDV; ++d0) { lo[s * NDV + d0] = vtr(vb + vrd + vq[d0] + s * VS); hv[s * NDV + d0] = vtr(vb + vrd + vq[d0] + s * VS + VH); }
#pragma unroll
                for (int s = 0; s < 4; ++s)
#pragma unroll
                    for (int d0 = 0; d0 < NDV; ++d0) { const s16x4 a_ = lo[s * NDV + d0], b_ = hv[s * NDV + d0];
                        const bf16x8 vf = {a_[0], a_[1], a_[2], a_[3], b_[0], b_[1], b_[2], b_[3]};
                        o[d0] = __builtin_amdgcn_mfma_f32_32x32x16_bf16(pa[s], vf, o[d0], 0, 0, 0); }
                __builtin_amdgcn_sched_group_barrier(0x100, 4, 1);
#pragma unroll
                for (int i = 0; i < 4 * NDV; ++i) { if (i + 2 < 4 * NDV) __builtin_amdgcn_sched_group_barrier(0x100, 2, 1); __builtin_amdgcn_sched_group_barrier(0x008, 1, 1); }
            }
        }
        if (t + 1 < nt) FA_LWRITE((t + 1) & 1);
        __syncthreads();
    }
#undef FA_GLOAD
#undef FA_LWRITE
    } else {
    unsigned kvo[NKC], vvo[NVC];
#pragma unroll
    for (int i_ = 0; i_ < NKC; ++i_) kvo[i_] = (MODE == 0 && i_ == 2) ? (unsigned)(kk * k2stride + 8 * cc) * 2u : (unsigned)(kk * kstride + 8 * (8 * i_ + cc)) * 2u;
#pragma unroll
    for (int i_ = 0; i_ < NVC; ++i_) vvo[i_] = (unsigned)((kvr + 32 * i_) * vstride + vgo) * 2u;
#define FA_GLOAD_K(t) do { const long j0_ = kt_first + 64 * (t); const char* kb0_ = (const char*)(kbase + j0_ * kstride); const char* kb2_ = (const char*)(k2base + j0_ * k2stride); \
        _Pragma("unroll") for (int i_ = 0; i_ < NKC; ++i_) { \
            if (MODE == 0 && i_ == 2) kst[i_] = *(const u32x4*)(kb2_ + kvo[i_]); \
            else kst[i_] = *(const u32x4*)(kb0_ + kvo[i_]); } } while (0)
#define FA_GLOAD_V(t) do { const long j0_ = kt_first + 64 * (t); const char* vb0_ = (const char*)(vbase + j0_ * vstride); \
        _Pragma("unroll") for (int i_ = 0; i_ < NVC; ++i_) vst[i_] = *(const u32x4*)(vb0_ + vvo[i_]); } while (0)
#define FA_LWRITE_K(kofs) do { LAS unsigned char* kb_ = lds + (kofs); \
        _Pragma("unroll") for (int i_ = 0; i_ < NKC; ++i_) *(LAS u32x4*)(kb_ + kwr + i_ * 8192) = kst[i_]; } while (0)
#define FA_LWRITE_V(bf) do { LAS unsigned char* vb_ = lds + OFF_V + (bf) * VMAXB; \
        _Pragma("unroll") for (int i_ = 0; i_ < NVC; ++i_) *(LAS u32x4*)(vb_ + vwr + i_ * 8192) = vst[i_]; } while (0)
#define FA_QK_H(P, kofs, koff) \
        { int ka_ = (kofs) + (koff) + krd; asm volatile("" : "+v"(ka_)); const LAS unsigned char* kb_ = lds + ka_; bf16x8 kf_[ND0]; \
          P = (f32x16){0.f, 0.f, 0.f, 0.f, 0.f, 0.f, 0.f, 0.f, 0.f, 0.f, 0.f, 0.f, 0.f, 0.f, 0.f, 0.f}; \
          _Pragma("unroll") for (int d0 = 0; d0 < ND0; ++d0) kf_[d0] = *(const LAS bf16x8*)(kb_ + d0 * 2048); \
          _Pragma("unroll") for (int d0 = 0; d0 < ND0; ++d0) P = __builtin_amdgcn_mfma_f32_32x32x16_bf16(kf_[d0], qf[d0], P, 0, 0, 0); }
#define FA_KPRE(kofs, koff) \
        { int ka_ = (kofs) + (koff) + krd; asm volatile("" : "+v"(ka_)); const LAS unsigned char* kb_ = lds + ka_; kpre0 = *(const LAS bf16x8*)(kb_); kpre1 = *(const LAS bf16x8*)(kb_ + 2048); }
#define FA_QK_HP(P, kofs, koff) \
        { int ka_ = (kofs) + (koff) + krd; asm volatile("" : "+v"(ka_)); const LAS unsigned char* kb_ = lds + ka_; bf16x8 kf_[ND0]; kf_[0] = kpre0; kf_[1] = kpre1; \
          P = (f32x16){0.f, 0.f, 0.f, 0.f, 0.f, 0.f, 0.f, 0.f, 0.f, 0.f, 0.f, 0.f, 0.f, 0.f, 0.f, 0.f}; \
          _Pragma("unroll") for (int d0 = 2; d0 < ND0; ++d0) kf_[d0] = *(const LAS bf16x8*)(kb_ + d0 * 2048); \
          _Pragma("unroll") for (int d0 = 0; d0 < ND0; ++d0) P = __builtin_amdgcn_mfma_f32_32x32x16_bf16(kf_[d0], qf[d0], P, 0, 0, 0); }
#define FA_VPRE(bf, s0) \
        { int a0_ = OFF_V + (bf) * VMAXB + (s0) * VS + vrd + vq[0], a1_ = OFF_V + (bf) * VMAXB + (s0) * VS + vrd + vq[1]; asm volatile("" : "+v"(a0_), "+v"(a1_)); \
          vplo0 = vtr(lds + a0_); vphv0 = vtr(lds + a0_ + VH); vplo1 = vtr(lds + a1_); vphv1 = vtr(lds + a1_ + VH); }
#define FA_PV_HP(bf, s0) \
        { s16x4 lo_[2 * NDV], hv_[2 * NDV]; const LAS unsigned char* vbd_[NDV]; \
          _Pragma("unroll") for (int d0 = 0; d0 < NDV; ++d0) { int a_ = OFF_V + (bf) * VMAXB + (s0) * VS + vrd + vq[d0]; asm volatile("" : "+v"(a_)); vbd_[d0] = lds + a_; } \
          lo_[0] = vplo0; hv_[0] = vphv0; lo_[1] = vplo1; hv_[1] = vphv1; \
          _Pragma("unroll") for (int s_ = 0; s_ < 2; ++s_) _Pragma("unroll") for (int d0 = 0; d0 < NDV; ++d0) { if (s_ * NDV + d0 >= 2) { lo_[s_ * NDV + d0] = vtr(vbd_[d0] + s_ * VS); hv_[s_ * NDV + d0] = vtr(vbd_[d0] + s_ * VS + VH); } } \
          _Pragma("unroll") for (int s_ = 0; s_ < 2; ++s_) _Pragma("unroll") for (int d0 = 0; d0 < NDV; ++d0) { const s16x4 a_ = lo_[s_ * NDV + d0], b_ = hv_[s_ * NDV + d0]; \
              const bf16x8 vf_ = {a_[0], a_[1], a_[2], a_[3], b_[0], b_[1], b_[2], b_[3]}; o[d0] = __builtin_amdgcn_mfma_f32_32x32x16_bf16(pa[s_], vf_, o[d0], 0, 0, 0); } }
#define FA_QKP_EXP_SGB \
        { constexpr int NV_ = (50 + ND0 - 1) / ND0, NT_ = (16 + ND0 - 1) / ND0; \
          _Pragma("unroll") for (int d0 = 0; d0 < ND0; ++d0) { if (d0 + 2 < ND0) __builtin_amdgcn_sched_group_barrier(0x100, 1, 0); __builtin_amdgcn_sched_group_barrier(0x008, 1, 0); \
              __builtin_amdgcn_sched_group_barrier(0x002, NV_, 0); __builtin_amdgcn_sched_group_barrier(0x400, NT_, 0); } \
          __builtin_amdgcn_sched_group_barrier(0x100, 4, 0); }
#define FA_PVP_SGB \
        { _Pragma("unroll") for (int i_ = 0; i_ < 2 * NDV; ++i_) { if (i_ + 2 < 2 * NDV) __builtin_amdgcn_sched_group_barrier(0x100, 2, 1); __builtin_amdgcn_sched_group_barrier(0x008, 1, 1); } \
          __builtin_amdgcn_sched_group_barrier(0x100, 2, 1); }
#define FA_QK_SGB \
        { __builtin_amdgcn_sched_group_barrier(0x100, 2, 0); \
          _Pragma("unroll") for (int d0 = 0; d0 < ND0; ++d0) { if (d0 + 2 < ND0) __builtin_amdgcn_sched_group_barrier(0x100, 1, 0); __builtin_amdgcn_sched_group_barrier(0x008, 1, 0); } }
#define FA_QK_EXP_SGB \
        { constexpr int NV_ = (48 + ND0 - 1) / ND0, NT_ = (16 + ND0 - 1) / ND0; \
          __builtin_amdgcn_sched_group_barrier(0x100, 2, 0); \
          _Pragma("unroll") for (int d0 = 0; d0 < ND0; ++d0) { if (d0 + 2 < ND0) __builtin_amdgcn_sched_group_barrier(0x100, 1, 0); __builtin_amdgcn_sched_group_barrier(0x008, 1, 0); \
              __builtin_amdgcn_sched_group_barrier(0x002, NV_, 0); __builtin_amdgcn_sched_group_barrier(0x400, NT_, 0); } }
#define FA_EXP_H(P) \
        { const float mnl_ = -m_reg * C2; float ps_ = 0.f; \
          _Pragma("unroll") for (int r = 0; r < 16; ++r) { P[r] = __builtin_amdgcn_exp2f(fmaf(P[r], C2, mnl_)); ps_ += P[r]; } \
          l_reg += ps_; \
          _Pragma("unroll") for (int s_ = 0; s_ < 2; ++s_) { u32x4 w_; \
              w_.x = cvt_pk_bf16(P[8 * s_ + 0], P[8 * s_ + 1]); w_.y = cvt_pk_bf16(P[8 * s_ + 2], P[8 * s_ + 3]); w_.z = cvt_pk_bf16(P[8 * s_ + 4], P[8 * s_ + 5]); w_.w = cvt_pk_bf16(P[8 * s_ + 6], P[8 * s_ + 7]); pa[s_] = __builtin_bit_cast(bf16x8, w_); } }
#define FA_MASK_H(P, tt, hh) \
        { const int tt_ = (tt); bool rowm_ = false, bandm_ = false; const int kt0_ = kt_first + 64 * tt_; \
          if (MODE == 1 && tt_ < 4 * blk) rowm_ = true; else if (!NOMASK) bandm_ = !(kt0_ + 63 <= qpos && (CAUSAL || kt0_ + (int)WD >= qpos + 31)); \
          if (rowm_) { if (!((selmask >> (tt_ >> 2)) & 1u)) { _Pragma("unroll") for (int r = 0; r < 16; ++r) P[r] = -INFINITY; } } \
          if (bandm_) { const int dq_ = qpos + c - kt0_ - 4 * hi - 32 * (hh); \
              _Pragma("unroll") for (int r = 0; r < 16; ++r) { if ((unsigned)(dq_ - ((r & 3) + 8 * (r >> 2))) > WD) P[r] = -INFINITY; } } }
#define FA_MAX_H(P, PM) \
        { float pm_ = fmaxf(P[0], P[1]); \
          _Pragma("unroll") for (int r = 2; r < 16; r += 2) pm_ = fmaxf(fmaxf(pm_, P[r]), P[r + 1]); \
          auto rr_ = __builtin_amdgcn_permlane32_swap(__float_as_uint(pm_), __float_as_uint(pm_), false, false); PM = fmaxf(__uint_as_float(rr_[0]), __uint_as_float(rr_[1])); }
#define FA_DECIDE(PM) \
        { if (!__all(((PM) - m_reg) * SCALE <= THR)) { \
              const float mn_ = fmaxf(m_reg, (PM)), alpha_ = __builtin_amdgcn_exp2f((m_reg - mn_) * C2); m_reg = mn_; l_reg *= alpha_; \
              if (hi == 0) al[c] = alpha_; \
              asm volatile("s_waitcnt lgkmcnt(0)" ::: "memory"); \
              _Pragma("unroll") for (int r = 0; r < 16; ++r) { const float f_ = alh[(r & 3) + 8 * (r >> 2)]; \
                  _Pragma("unroll") for (int d0 = 0; d0 < NDV; ++d0) o[d0][r] *= f_; } \
              asm volatile("s_waitcnt lgkmcnt(0)" ::: "memory"); } }
#define FA_PV_H(bf, s0) \
        { s16x4 lo_[2 * NDV], hv_[2 * NDV]; const LAS unsigned char* vbd_[NDV]; \
          _Pragma("unroll") for (int d0 = 0; d0 < NDV; ++d0) { int a_ = OFF_V + (bf) * VMAXB + (s0) * VS + vrd + vq[d0]; asm volatile("" : "+v"(a_)); vbd_[d0] = lds + a_; }     \
          _Pragma("unroll") for (int s_ = 0; s_ < 2; ++s_) _Pragma("unroll") for (int d0 = 0; d0 < NDV; ++d0) { lo_[s_ * NDV + d0] = vtr(vbd_[d0] + s_ * VS); hv_[s_ * NDV + d0] = vtr(vbd_[d0] + s_ * VS + VH); } \
          _Pragma("unroll") for (int s_ = 0; s_ < 2; ++s_) _Pragma("unroll") for (int d0 = 0; d0 < NDV; ++d0) { const s16x4 a_ = lo_[s_ * NDV + d0], b_ = hv_[s_ * NDV + d0]; \
              const bf16x8 vf_ = {a_[0], a_[1], a_[2], a_[3], b_[0], b_[1], b_[2], b_[3]}; o[d0] = __builtin_amdgcn_mfma_f32_32x32x16_bf16(pa[s_], vf_, o[d0], 0, 0, 0); } \
          __builtin_amdgcn_sched_group_barrier(0x100, 4, 1); \
          _Pragma("unroll") for (int i_ = 0; i_ < 2 * NDV; ++i_) { if (i_ + 2 < 2 * NDV) __builtin_amdgcn_sched_group_barrier(0x100, 2, 1); __builtin_amdgcn_sched_group_barrier(0x008, 1, 1); } }
    {
        f32x16 pA, pB;
        bf16x8 kpre0, kpre1; s16x4 vplo0, vphv0, vplo1, vphv1;
        FA_GLOAD_K(0); FA_GLOAD_V(0); FA_LWRITE_K(0); FA_LWRITE_V(0);
        if (nt > 1) { FA_GLOAD_K(1); FA_LWRITE_K(KMAXB); }
        __syncthreads();
        { FA_QK_H(pA, 0, 0) FA_QK_SGB }
        float pmA, pmB;
        FA_MASK_H(pA, 0, 0)
        FA_MAX_H(pA, pmA)
        FA_KPRE(0, 512)
        int kc = 0, kn = KMAXB, kw = 2 * KMAXB;
        const int ntw = CAUSAL ? nt - 3 + (wave >> 1) : nt;
        for (int t = 0; t < nt; ++t) {
            if (t + 2 < nt) FA_GLOAD_K(t + 2);
            if (t + 1 < nt) FA_GLOAD_V(t + 1);
            if (t < ntw) {
            bf16x8 pa[2];
            FA_DECIDE(pmA)
            __builtin_amdgcn_sched_barrier(0);
            { FA_QK_HP(pB, kc, 512) FA_EXP_H(pA) FA_VPRE(t & 1, 0) FA_QKP_EXP_SGB }
            __builtin_amdgcn_sched_barrier(0);
            FA_MASK_H(pB, t, 1)
            __builtin_amdgcn_sched_barrier(0);
            { FA_PV_HP(t & 1, 0) FA_MAX_H(pB, pmB) FA_KPRE(kn, 0) FA_PVP_SGB }
            __builtin_amdgcn_sched_barrier(0);
            FA_DECIDE(pmB)
            __builtin_amdgcn_sched_barrier(0);
            if (t + 1 < ntw) { FA_QK_HP(pA, kn, 0) FA_EXP_H(pB) FA_VPRE(t & 1, 2) FA_QKP_EXP_SGB }
            else { FA_EXP_H(pB) FA_VPRE(t & 1, 2) }
            __builtin_amdgcn_sched_barrier(0);
            if (t + 1 < ntw) FA_MASK_H(pA, t + 1, 0)
            __builtin_amdgcn_sched_barrier(0);
            { FA_PV_HP(t & 1, 2) FA_MAX_H(pA, pmA) FA_KPRE(kn, 512) FA_PVP_SGB }
            __builtin_amdgcn_sched_barrier(0);
            }
            if (t + 2 < nt) FA_LWRITE_K(kw);
            if (t + 1 < nt) FA_LWRITE_V((t + 1) & 1);
            __syncthreads();
            { const int tmp_ = kc; kc = kn; kn = kw; kw = tmp_; }
        }
    }
#undef FA_GLOAD_K
#undef FA_GLOAD_V
#undef FA_LWRITE_K
#undef FA_LWRITE_V
#undef FA_QK_H
#undef FA_QK_SGB
#undef FA_KPRE
#undef FA_QK_HP
#undef FA_VPRE
#undef FA_PV_HP
#undef FA_QKP_EXP_SGB
#undef FA_PVP_SGB
#undef FA_QK_EXP_SGB
#undef FA_EXP_H
#undef FA_MASK_H
#undef FA_MAX_H
#undef FA_DECIDE
#undef FA_PV_H
    }
    constexpr int CPR = DV / 8, NGI = 32 * CPR / 64;
    u32x4 gpre[NGI];
    if (MODE != 4) {
#pragma unroll
        for (int i = 0; i < NGI; ++i) { const int q = lane + 64 * i, row = q / CPR, ch = q % CPR; gpre[i] = *(const u32x4*)(H + (tok0 + tokstep * row) * LDH + ycol + ch * 8); }
    }
    const float lt = sum_x32(l_reg);
    float fin = 1.0f / lt;
    const float lse = m_reg * SCALE + __logf(lt);
    if (MODE == 3) fin *= 1.0f / (1.0f + __expf(sinks[hh] - lse));
    if (hi == 0) li[c] = fin;
    asm volatile("s_waitcnt lgkmcnt(0)" ::: "memory");
    LAS bf16_t* stg = (LAS bf16_t*)(lds + OFF_STG + wave * 8192); LAS bf16_t* stgl = stg + 4 * hi * DV + c;
#pragma unroll
    for (int r = 0; r < 16; ++r) { const int cr = (r & 3) + 8 * (r >> 2); const float f = lih[cr];
#pragma unroll
        for (int d0 = 0; d0 < NDV; ++d0) stgl[cr * DV + 32 * d0] = (bf16_t)(cvt_pk_bf16(o[d0][r] * f, 0.f) & 0xffffu); }
    asm volatile("s_waitcnt lgkmcnt(0)" ::: "memory");
#pragma unroll
    for (int i = 0; i < NGI; ++i) {
        const int q = lane + 64 * i, row = q / CPR, ch = q % CPR;
        const u32x4 v = *(const LAS u32x4*)(stg + row * DV + ch * 8);
        const long tok = tok0 + tokstep * row;
        if (MODE == 4) { *(u32x4*)((bf16_t*)(ws + ws_op(pat)) + (size_t)tok * 768 + hh * 128 + ch * 8) = v; }
        else {
            bf16_t* yp = H + tok * LDH + ycol + ch * 8; const u32x4 g = gpre[i]; u32x4 w;
#define FA_GATE(vv, gg) cvt_pk_bf16(__uint_as_float((vv) << 16) * silu(__uint_as_float((gg) << 16)), __uint_as_float((vv) & 0xffff0000u) * silu(__uint_as_float((gg) & 0xffff0000u)))
            w.x = FA_GATE(v.x, g.x); w.y = FA_GATE(v.y, g.y); w.z = FA_GATE(v.z, g.z); w.w = FA_GATE(v.w, g.w);
#undef FA_GATE
            *(u32x4*)yp = w;
        }
    }
    if (MODE == 4 && hi == 0) ((float*)(ws + WS_LSE))[((size_t)pat * T + tok0 + tokstep * c) * 6 + hh] = lse;
}
}

#define XB_TMO      128
#define XB_XCNT(j)  (256  + 64 * (j))
#define XB_XSUB(j)  (1280 + 64 * (j))
#define XB_XGEN(j)  (2304 + 64 * (j))
#define XB_TOP      3328
#define XB_TOPGEN   3392
#define XCD_BAR_WORDS 3456
#define XB_SPIN_CAP (1u << 22)
__device__ __forceinline__ unsigned xb_ld(unsigned* p)              { return __hip_atomic_load(p, __ATOMIC_RELAXED, __HIP_MEMORY_SCOPE_AGENT); }
__device__ __forceinline__ unsigned xb_add(unsigned* p, unsigned v) { return __hip_atomic_fetch_add(p, v, __ATOMIC_RELAXED, __HIP_MEMORY_SCOPE_AGENT); }
__device__ __forceinline__ unsigned xb_xcc_id() { return (unsigned)__builtin_amdgcn_s_getreg((3 << 11) | 20) & 0xFu; }
#define XB_SPIN(cond, bar) do { unsigned _sp = 0; while (cond) { __builtin_amdgcn_s_sleep(1); \
    if ((++_sp & 255u) == 0u) { if (xb_ld(&(bar)[XB_TMO])) break; if (_sp > XB_SPIN_CAP) { atomicAdd(&(bar)[XB_TMO], 1u); break; } } } } while (0)
__device__ __forceinline__ void xcd_barrier_complete(unsigned* bar, unsigned x, unsigned& nloc, unsigned& nx) {
    const unsigned G = gridDim.x; unsigned sum, cnt, mine, sp = 0u;
    for (;;) {
        sum = 0u; cnt = 0u; mine = 0u;
#pragma unroll
        for (unsigned j = 0; j < 16; ++j) { const unsigned c = xb_ld(&bar[XB_XCNT(j)]); sum += c; cnt += (c > 0u) ? 1u : 0u; mine = (j == x) ? c : mine; }
        if (sum == G) break;
        __builtin_amdgcn_s_sleep(1);
        if ((++sp & 255u) == 0u) { if (xb_ld(&bar[XB_TMO])) break; if (sp > XB_SPIN_CAP) { atomicAdd(&bar[XB_TMO], 1u); break; } }
    }
    nloc = mine > 0u ? mine : 1u; nx = cnt > 0u ? cnt : 1u;
}
__device__ __forceinline__ void grid_barrier(unsigned* bar, volatile LAS unsigned* st, const int wave_s) {
    asm volatile("s_waitcnt vmcnt(0)" ::: "memory");
    __syncthreads();
    if (wave_s == 0 && lane_id() == 0) {
        const unsigned x = xb_xcc_id();
        __builtin_amdgcn_s_waitcnt(0);
        unsigned nloc = st[0], nx = st[1];
        if (nloc == 0u) { xcd_barrier_complete(bar, x, nloc, nx); st[0] = nloc; st[1] = nx; }
        const unsigned old = xb_add(&bar[XB_XSUB(x)], 1u);
        const unsigned gen = old / nloc;
        if (old + 1u == (gen + 1u) * nloc) {
            __builtin_amdgcn_fence(__ATOMIC_RELEASE, "agent");
            asm volatile("s_waitcnt vmcnt(0)" ::: "memory");
            const unsigned og = xb_add(&bar[XB_TOP], 1u);
            const unsigned tg = og / nx;
            if (og + 1u == (tg + 1u) * nx) {
#pragma unroll
                for (unsigned j = 0; j < 16; ++j) (void)xb_add(&bar[XB_XGEN(j)], 1u);
            } else XB_SPIN(xb_ld(&bar[XB_XGEN(x)]) == gen, bar);
            __builtin_amdgcn_fence(__ATOMIC_ACQUIRE, "agent");
            asm volatile("s_waitcnt vmcnt(0)" ::: "memory");
        } else {
            XB_SPIN(xb_ld(&bar[XB_XGEN(x)]) == gen, bar);
            __builtin_amdgcn_fence(__ATOMIC_ACQUIRE, "agent");
            asm volatile("s_waitcnt vmcnt(0)" ::: "memory");
        }
    }
    __syncthreads();
}

__device__ __forceinline__ int opaque_tid(int wave_s) { int t = wave_s * 64 + lane_id(); asm volatile("" : "+v"(t)); return t; }

constexpr int LDS_BYTES = 155648;
static_assert(fa::LDS_NEED <= LDS_BYTES - 64, "LDS map");
__global__ void __launch_bounds__(512, 2) mega(Args args) {
    extern __shared__ __attribute__((aligned(16))) unsigned char lds_raw[];
    LAS unsigned char* lds = (LAS unsigned char*)lds_raw;
    const int G = gridDim.x, NGW = G * 8;
    const int wave_s = __builtin_amdgcn_readfirstlane((int)threadIdx.x >> 6);
#define PHASE_IDS const int tid = opaque_tid(wave_s), lane = tid & 63, wave = wave_s, gw = blockIdx.x * 8 + wave; (void)lane; (void)gw;
#define KA() ({ auto p_ = __builtin_amdgcn_kernarg_segment_ptr(); asm volatile("" : "+s"(p_)); (const __attribute__((address_space(4))) Args*)p_; })
    unsigned char* ws = KA()->ws;
    const int lo = KA()->ph_lo, hi = KA()->ph_hi;
#define IN(k) (lo <= (k) && (k) < hi)
#define SEAM(k) do { if (IN(k) && IN((k) + 1)) { grid_barrier((unsigned*)(ws + WS_CTL) + 1024, (volatile LAS unsigned*)(lds + LDS_BYTES - 64), wave_s); } } while (0)
    if (lane_id() < 16 && wave_s == 0) ((LAS unsigned*)(lds + LDS_BYTES - 64))[lane_id()] = 0u;
    __syncthreads();
    if (hi - lo > 1 && wave_s == 0 && lane_id() == 0) (void)xb_add((unsigned*)(ws + WS_CTL) + 1024 + XB_XCNT(xb_xcc_id()), 1u);
    if (lo < 0) cg::this_grid().sync();
#define W1E ((bf16_t*)(ws + WS_W1E))
#define WUQ ((bf16_t*)(ws + WS_WUQ))
#define WUKV ((bf16_t*)(ws + WS_WUKV))
#define WMKE ((bf16_t*)(ws + WS_WMKE))
#define WOE ((bf16_t*)(ws + WS_WOE))
#define W1O ((bf16_t*)(ws + WS_W1O))
#define WMKO ((bf16_t*)(ws + WS_WMKO))
#define WOO ((bf16_t*)(ws + WS_WOO))
#define XB ((bf16_t*)(ws + WS_R1))
#define QA ((bf16_t*)KA()->out)
#define KVA ((bf16_t*)(ws + WS_KVA))
#define H ((bf16_t*)(ws + WS_H))
#define MEMB ((bf16_t*)(ws + WS_MEMB))
#define MKVE ((bf16_t*)(ws + WS_MKVE))
#define MKVO ((bf16_t*)(ws + WS_MKVO))
#define CS64 ((f32x2*)(ws + WS_CS64))
#define CS32 ((f32x2*)(ws + WS_CS32))
#define CS16 ((f32x2*)(ws + WS_CS16))
#define RS0 ((float*)(ws + WS_RS0))
#define SSQQ ((float*)(ws + WS_SSQQ))
#define SSQKV ((float*)(ws + WS_SSQKV))
#define SSQ1 ((float*)(ws + WS_SSQ1))
#define SSQ2 ((float*)(ws + WS_SSQ2))
#define RSMEM ((float*)(ws + WS_RSMEM))
#define KMEAN ((float*)(ws + WS_KMEAN))
    if (IN(0)) {
        PHASE_IDS
        LAS float* scr = (LAS float*)(lds + wave * 16640);
        constexpr int I0 = 32 * 112, I1 = 8 * 24, I2 = 4 * 32, I3 = 32 * 16, I6 = 32 * 16;
        constexpr int total = I0 + I1 + I2 + I3 + I6;
        for (int it = gw; it < total; it += NGW) {
            int r = it;
            if (r < I0) { transpose_item(KA()->in[3], 2048, 6976, W1E, KA()->in[2], 0, scr, r, 112, lane); continue; } r -= I0;
            if (r < I1) { transpose_item(KA()->in[5], 512, 1536, WUQ, KA()->in[4], 1, scr, r, 24, lane); continue; } r -= I1;
            if (r < I2) { transpose_item(KA()->in[7], 256, 2048, WUKV, KA()->in[6], 2, scr, r, 32, lane); continue; } r -= I2;
            if (r < I3) { transpose_item(KA()->in[9], 2048, 1024, WMKE, KA()->in[8], 3, scr, r, 16, lane); continue; } r -= I3;
            transpose_item(KA()->in[15], 2048, 1024, WMKO, KA()->in[14], 6, scr, r, 16, lane);
        }
        for (int m = gw - total % NGW + (gw < total % NGW ? NGW : 0); m < T + NB * NMEM; m += NGW) {
            if (m < T) row_to_bf16(KA()->in[0] + (size_t)m * DM, XB + (size_t)m * DM, RS0 + m, lane);
            else { const int mm = m - T; row_to_bf16(KA()->in[1] + (size_t)mm * DM, MEMB + (size_t)mm * DM, RSMEM + mm, lane); }
        }
        const int gt = blockIdx.x * 512 + tid, NGT = G * 512;
        for (int i = gt; i < SEQ * 56; i += NGT) {
            const int pos = i / 56, j = i - pos * 56; int rot, fi; f32x2* dst;
            if (j < 32) { rot = 64; fi = j; dst = CS64 + pos * 32 + fi; } else if (j < 48) { rot = 32; fi = j - 32; dst = CS32 + pos * 16 + fi; } else { rot = 16; fi = j - 48; dst = CS16 + pos * 8 + fi; }
            const float inv = 1.0f / powf(500000.0f, (float)(2 * fi) / (float)rot);
            const float ang = (float)pos * inv; float sn, cs; sincosf(ang, &sn, &cs);
            *dst = (f32x2){cs, sn};
        }
        for (int i = gt; i < T; i += NGT) { SSQQ[i] = 0.f; SSQKV[i] = 0.f; SSQ1[i] = 0.f; SSQ2[i] = 0.f; }
        if (gt < 64) ((unsigned*)(ws + WS_CTL))[gt] = 0u;
    }
    SEAM(0);
    if (IN(1)) {
        EpiBF<0> E{H, LDH0, RS0, nullptr, 0.f, SSQQ, SSQKV, CS64, CS32, CS16};
        run_gemm(lds, XB, DM, W1E, T, LDH0, DM, E, 0, wave_s);
    }
    SEAM(1);
    if (IN(2)) {
        PHASE_IDS
        for (int it0 = (int)blockIdx.x * 2; it0 < 512; it0 += G * 2) {
            const int it = it0 + (wave >> 2), q = wave & 3;
            const int b = it >> 7, n = (it >> 3) & 15, hh = it & 7;
            const bf16_t* kp = H + (size_t)(b * SEQ + n * 256 + q * 64) * LDH0 + E_KB + hh * 128 + 2 * lane; float s0 = 0.f, s1 = 0.f;
#pragma unroll 16
            for (int j = 0; j < 64; ++j) { const unsigned w = *(const unsigned*)(kp + (size_t)j * LDH0); s0 += __uint_as_float(w << 16); s1 += __uint_as_float(w & 0xffff0000u); }
            LAS float* part = (LAS float*)lds + wave * 128; part[2 * lane] = s0; part[2 * lane + 1] = s1;
            __syncthreads();
            if (q == 0) {
                const LAS float* p0 = (const LAS float*)lds + wave * 128 + 2 * lane;
                const float t0 = ((p0[0] + p0[128]) + p0[256]) + p0[384], t1 = ((p0[1] + p0[129]) + p0[257]) + p0[385];
                float* km = KMEAN + ((size_t)((b * 8 + hh) * 16 + n)) * 128 + 2 * lane; km[0] = t0 * (1.f / 256.f); km[1] = t1 * (1.f / 256.f);
            }
            __syncthreads();
        }
        { EpiBF<4> E{MKVE, 1024, RSMEM, nullptr, 0.f, nullptr, nullptr, CS64, CS32, CS16}; run_gemm(lds, MEMB, DM, WMKE, NB * NMEM, 1024, DM, E, 0, wave_s); }
        { EpiBF<4> E{MKVO, 1024, RSMEM, nullptr, 0.f, nullptr, nullptr, CS64, CS32, CS16}; run_gemm(lds, MEMB, DM, WMKO, NB * NMEM, 1024, DM, E, 240, wave_s); }
        { EpiBF<1> E{QA, 1536, nullptr, SSQQ, 1.f / 512.f, nullptr, nullptr, CS64, CS32, CS16}; pg8::StaticOrder S; S.init(T, 1536, G == 256 ? 224 : G, G == 256 ? (int)blockIdx.x - 32 : (int)blockIdx.x); run_gemm_s(lds, H + E_CQ, LDH0, WUQ, T, 1536, 512, E, S, wave_s); }
                { EpiBF<2> E{KVA, 2048, nullptr, SSQKV, 1.f / 256.f, nullptr, nullptr, CS64, CS32, CS16};
          pg8::StaticOrder S; int c2 = (int)blockIdx.x;
          if (G == 256) { c2 -= 32; if (c2 >= 0) c2 = c2 >= 160 ? c2 - 160 : c2 + 64; }
          S.init(T, 2048, G == 256 ? 224 : G, c2); run_gemm_s(lds, H + E_CKV, LDH0, WUKV, T, 2048, 256, E, S, wave_s); }
    }
    SEAM(2);
    if (IN(3)) {
        PHASE_IDS
        unsigned* ctr = (unsigned*)(ws + WS_CTL); volatile LAS unsigned* qw = (volatile LAS unsigned*)(lds + fa::OFF_Q);
        for (;;) {
            if (tid == 0) qw[0] = atomicAdd(ctr, 1u);
            __syncthreads();
            const int it = __builtin_amdgcn_readfirstlane((int)qw[0]);
            __syncthreads();
            if (it >= 1280 + 704) break;
            int ia = it, ic = -1;
            if (it >= 256) { const int j = it - 256, blk = j / 27, r = j - blk * 27, nc = (r * 11) / 27; if (((r + 1) * 11) / 27 > nc) ic = blk * 11 + nc; else ia = 256 + blk * 16 + (r - nc); }
            if (ic >= 0) {
                constexpr int I4 = 40 * 32, I5 = 32 * 100;
                LAS float* scr = (LAS float*)(lds + (wave < 6 ? wave * 16640 : 108800 + (wave - 6) * 16640));
                int r = ic * 8 + wave;
                int ln = lane_id(); asm volatile("" : "+v"(ln));
                if (r < I4) transpose_item(KA()->in[10], 2560, 2048, WOE, nullptr, 4, scr, r, 32, ln);
                else if (r < I4 + I5) transpose_item(KA()->in[12], 2048, 6400, W1O, KA()->in[11], 5, scr, r - I4, 100, ln);
                else transpose_item(KA()->in[16], 2304, 2048, WOO, nullptr, 7, scr, r - I4 - I5, 32, ln);
                continue;
            }
            if (ia < 1024) { const int item = (ia & ~63) / 2 + (ia & 31); if (((ia >> 5) & 1) == 0) fa::attn_item<0>(lds, ws, (const float*)KA()->out, item, wave_s); else fa::attn_item<1>(lds, ws, KA()->in[13], item, wave_s); }
            else fa::attn_item<2>(lds, ws, KA()->in[13], ia - 1024, wave_s);
        }
    }
    SEAM(3);
    if (IN(4)) {
        EpiRes<true, false> E{XB, nullptr, XB, DM, SSQ1};
        run_gemm(lds, H + E_G, LDH0, WOE, T, DM, 2560, E, 0, wave_s, WGM_OUT);
    }
    SEAM(4);
    if (IN(5)) {
        EpiBF<3> E{H, LDH1, nullptr, SSQ1, 1.f / DM, nullptr, nullptr, CS64, CS32, CS16};
        run_gemm(lds, XB, DM, W1O, T, 6144, DM, E, 0, wave_s);
    }
    SEAM(5);
    if (IN(6)) {
        PHASE_IDS
        if (blockIdx.x < 64) {
            EpiBF<3> E{H, LDH1, nullptr, SSQ1, 1.f / DM, nullptr, nullptr, CS64, CS32, CS16}; TailUnits S1{(int)blockIdx.x, G, 64, 24};
            run_gemm_s(lds, XB, DM, W1O, T, LDH1, DM, E, S1, wave_s);
            asm volatile("s_waitcnt vmcnt(0)" ::: "memory"); __syncthreads();
            if (tid == 0) { __builtin_amdgcn_fence(__ATOMIC_RELEASE, "agent"); asm volatile("s_waitcnt vmcnt(0)" ::: "memory"); __hip_atomic_fetch_add((unsigned*)(ws + WS_CTL) + 32, (unsigned)((64 - (int)blockIdx.x + G - 1) / G), __ATOMIC_RELAXED, __HIP_MEMORY_SCOPE_AGENT); }
        }
        unsigned* ctr = (unsigned*)(ws + WS_CTL) + 16; volatile LAS unsigned* qw = (volatile LAS unsigned*)(lds + fa::OFF_Q);
        unsigned nxt_ = 0u; if (tid == 0) nxt_ = atomicAdd(ctr, 1u);
        for (;;) {
            if (tid == 0) qw[0] = nxt_;
            __syncthreads();
            const int it = __builtin_amdgcn_readfirstlane((int)qw[0]);
            __syncthreads();
            if (it >= 1152 + 256 + 1024) break;
            if (tid == 0) nxt_ = atomicAdd(ctr, 1u);
            unsigned* tailcnt = (unsigned*)(ws + WS_CTL) + 32;
            const int it2 = it;
            if (it2 < 1152) fa::attn_item<4>(lds, ws, KA()->in[13], it2, wave_s);
            else if (it2 < 1408) {
                if (((it2 - 1152) >> 4) & 2) {
                    if (tid == 0) { unsigned sp = 0; while (__hip_atomic_load(tailcnt, __ATOMIC_RELAXED, __HIP_MEMORY_SCOPE_AGENT) < 64u && ++sp < (1u << 24)) __builtin_amdgcn_s_sleep(4);
                                    __builtin_amdgcn_fence(__ATOMIC_ACQUIRE, "agent"); asm volatile("s_waitcnt vmcnt(0)" ::: "memory"); }
                    __syncthreads();
                }
                fa::attn_item<5>(lds, ws, KA()->in[13], it2 - 1152, wave_s);
            }
            else fa::attn_item<3>(lds, ws, KA()->in[13], it2 - 1408, wave_s);
        }
    }
    SEAM(6);
    if (IN(7)) {
        PHASE_IDS
        const bf16_t* OP0 = (const bf16_t*)(ws + ws_op(0)); const bf16_t* OP1 = (const bf16_t*)(ws + ws_op(1)); const bf16_t* OP2 = (const bf16_t*)(ws + ws_op(2)); const float* LSE = (const float*)(ws + WS_LSE);
        for (int q = blockIdx.x * 512 + tid; q < T * 96; q += G * 512) {
            const int tok = q / 96, ch = q - tok * 96, hd = ch >> 4;
            const float l0 = LSE[(size_t)tok * 6 + hd], l1 = LSE[((size_t)T + tok) * 6 + hd], l2 = LSE[((size_t)2 * T + tok) * 6 + hd];
            const float mx = fmaxf(l0, fmaxf(l1, l2)); float w0 = __expf(l0 - mx), w1 = __expf(l1 - mx), w2 = __expf(l2 - mx); const float iw = 1.0f / (w0 + w1 + w2); w0 *= iw; w1 *= iw; w2 *= iw;
            const u32x4 a = *(const u32x4*)(OP0 + (size_t)tok * 768 + ch * 8), b = *(const u32x4*)(OP1 + (size_t)tok * 768 + ch * 8), c2 = *(const u32x4*)(OP2 + (size_t)tok * 768 + ch * 8);
            bf16_t* yp = H + (size_t)tok * LDH1 + O_G + 1024 + ch * 8; const u32x4 g = *(const u32x4*)yp; u32x4 w;
#define MIX(aa, bb, cc_, gg) cvt_pk_bf16((w0 * __uint_as_float((aa) << 16) + w1 * __uint_as_float((bb) << 16) + w2 * __uint_as_float((cc_) << 16)) * fa::silu(__uint_as_float((gg) << 16)), \
                (w0 * __uint_as_float((aa) & 0xffff0000u) + w1 * __uint_as_float((bb) & 0xffff0000u) + w2 * __uint_as_float((cc_) & 0xffff0000u)) * fa::silu(__uint_as_float((gg) & 0xffff0000u)))
            w.x = MIX(a.x, b.x, c2.x, g.x); w.y = MIX(a.y, b.y, c2.y, g.y); w.z = MIX(a.z, b.z, c2.z, g.z); w.w = MIX(a.w, b.w, c2.w, g.w);
#undef MIX
            *(u32x4*)yp = w;
        }
    }
    SEAM(7);
    if (IN(8)) {
        if (G == 256 && WGM_OUT == 4) { EpiFinal E{XB, KA()->out, DM, SSQ2, (unsigned*)(ws + WS_CTL) + 8192, KA()->in[17]}; run_gemm(lds, H + O_G, LDH1, WOO, T, DM, 2304, E, 0, wave_s, WGM_OUT); }
        else { EpiRes<true, false> E{XB, nullptr, XB, DM, SSQ2}; run_gemm(lds, H + O_G, LDH1, WOO, T, DM, 2304, E, 0, wave_s, WGM_OUT); }
    }
    if (!(G == 256 && WGM_OUT == 4)) SEAM(8);
    if (IN(9) && !(G == 256 && WGM_OUT == 4)) {
        PHASE_IDS
        const f32x4* gp = (const f32x4*)KA()->in[17] + 2 * lane;
        for (int m = gw; m < T; m += NGW) {
            const float r = 1.0f / sqrtf(SSQ2[m] * (1.0f / DM) + EPS);
            const u32x4* xr = (const u32x4*)(XB + (size_t)m * DM) + lane; f32x4* orow = (f32x4*)(KA()->out + (size_t)m * DM) + 2 * lane;
            u32x4 w[4];
#pragma unroll
            for (int j = 0; j < 4; ++j) w[j] = xr[64 * j];
#pragma unroll
            for (int j = 0; j < 4; ++j) { const f32x4 g0 = gp[128 * j], g1 = gp[128 * j + 1];
                f32x4 v0 = {__uint_as_float(w[j].x << 16), __uint_as_float(w[j].x & 0xffff0000u), __uint_as_float(w[j].y << 16), __uint_as_float(w[j].y & 0xffff0000u)};
                f32x4 v1 = {__uint_as_float(w[j].z << 16), __uint_as_float(w[j].z & 0xffff0000u), __uint_as_float(w[j].w << 16), __uint_as_float(w[j].w & 0xffff0000u)};
                v0 = v0 * r; v0 = v0 * g0; v1 = v1 * r; v1 = v1 * g1; orow[128 * j] = v0; orow[128 * j + 1] = v1; }
        }
    }
#undef KA
#undef PHASE_IDS
#undef IN
#undef SEAM
#undef W1E
#undef WUQ
#undef WUKV
#undef WMKE
#undef WOE
#undef W1O
#undef WMKO
#undef WOO
#undef XB
#undef QA
#undef KVA
#undef H
#undef MEMB
#undef MKVE
#undef MKVO
#undef CS64
#undef CS32
#undef CS16
#undef RS0
#undef SSQQ
#undef SSQKV
#undef SSQ1
#undef SSQ2
#undef RSMEM
#undef KMEAN
}

extern "C" void kernel_launch(void* const* d_in, const int* in_sizes, int n_in, void* d_out, int out_size, void* d_ws, size_t ws_size, hipStream_t stream) {
    static int grid = 0;
    if (grid == 0) {
        if (n_in != 18 || out_size != T * DM || ws_size < WS_END) { fprintf(stderr, "kernel_launch: unexpected shapes (n_in %d out %d ws %zu)\n", n_in, out_size, ws_size); grid = -1; return; }
        int dev = 0, cus = 0, per_cu = 0;
        (void)hipGetDevice(&dev); (void)hipDeviceGetAttribute(&cus, hipDeviceAttributeMultiprocessorCount, dev);
        if (hipFuncSetAttribute((const void*)mega, hipFuncAttributeMaxDynamicSharedMemorySize, LDS_BYTES) != hipSuccess) { fprintf(stderr, "kernel_launch: hipFuncSetAttribute failed\n"); grid = -1; return; }
        (void)hipOccupancyMaxActiveBlocksPerMultiprocessor(&per_cu, (const void*)mega, 512, LDS_BYTES);
        if (per_cu < 1) { fprintf(stderr, "kernel_launch: occupancy query says %d\n", per_cu); per_cu = 1; }
        grid = (cus > 0 ? cus : 256) * 1;
        (void)hipGetLastError();
    }
    if (grid < 0) return;
    (void)hipMemsetAsync((unsigned char*)d_ws + WS_CTL, 0, 65536, stream);
    Args a{};
    for (int i = 0; i < 18; ++i) a.in[i] = (const float*)d_in[i];
    a.out = (float*)d_out; a.ws = (unsigned char*)d_ws;
    a.ph_lo = 0; a.ph_hi = 10;
    void* kargs[] = {&a};
    hipError_t e = hipLaunchCooperativeKernel((const void*)mega, dim3(grid), dim3(512), kargs, LDS_BYTES, stream);
    if (e != hipSuccess) fprintf(stderr, "kernel_launch: cooperative launch failed: %s (grid %d)\n", hipGetErrorString(e), grid);

}
```
